# Optimizing an MI355X kernel written in HIP

```python
import math
import jax, jax.numpy as jnp
from jax import lax
import numpy as np

D_MODEL = 1024
BATCH = 4
SEQ = 8192
DEPTH = 2
DEC_BATCH = 16
DEC_SEQ = 2048
PAST_LEN = 128

GRID_W = 64
HEAD_DIM = 64
D_FF = 2816
N_BRANCH = 4
BRANCH_W = 512
CONV_W = BRANCH_W
POOL_W = BRANCH_W
POOL_WINDOWS = (2, 4, 8, 16)
POOL_GROUP = POOL_W // 4
GQA_HEADS = 8
GQA_KV = 2
GQA_GROUP = GQA_HEADS // GQA_KV
DIFF_HEADS = 4
DIFF_V = 2 * HEAD_DIM
AXIAL_THETA = 10000.0
ROPE_THETA = 500000.0
ROPE_DIM = HEAD_DIM // 4
Q_BLOCK = 128
EPS = 1e-6
IN_SIZES = (CONV_W, CONV_W, CONV_W, POOL_W,
            GQA_HEADS * HEAD_DIM, GQA_KV * HEAD_DIM, GQA_KV * HEAD_DIM,
            DIFF_HEADS * 2 * HEAD_DIM, DIFF_HEADS * 2 * HEAD_DIM, DIFF_HEADS * DIFF_V,
            N_BRANCH * D_MODEL)
IN_W = sum(IN_SIZES)

kernel_name = "hybrid_gated_conv_pool_gqa_diff_encoder"


def rms_norm(x, g):
    xf = x.astype(jnp.float32)
    y = xf * lax.rsqrt(jnp.mean(xf * xf, axis=-1, keepdims=True) + EPS)
    return (y * g.astype(jnp.float32)).astype(x.dtype)


def swiglu(x, g, w_in, w_out):
    h = rms_norm(x, g) @ w_in
    a, b = jnp.split(h, 2, axis=-1)
    return (jax.nn.silu(a) * b) @ w_out


def rope(x, pos, theta):
    n = x.shape[-1]
    half = n // 2
    freqs = jnp.exp(-math.log(theta) * jnp.arange(half, dtype=jnp.float32) * (2.0 / n))
    ang = pos.astype(jnp.float32)[:, None] * freqs[None, :]
    shp = (ang.shape[0],) + (1,) * (x.ndim - 3) + (half,)
    cos = jnp.cos(ang).reshape(shp)
    sin = jnp.sin(ang).reshape(shp)
    xf = x.astype(jnp.float32)
    x1, x2 = xf[..., :half], xf[..., half:]
    return jnp.concatenate([x1 * cos - x2 * sin, x2 * cos + x1 * sin], axis=-1).astype(x.dtype)


def axial_rope(x, row, col):
    half = HEAD_DIM // 2
    return jnp.concatenate([rope(x[..., :half], row, AXIAL_THETA),
                            rope(x[..., half:], col, AXIAL_THETA)], axis=-1)


def partial_rope(x, pos):
    return jnp.concatenate([rope(x[..., :ROPE_DIM], pos, ROPE_THETA), x[..., ROPE_DIM:]], axis=-1)


def short_conv(xin, b_gate, c_gate, w):
    z = c_gate * xin
    zp = jnp.pad(z, ((0, 0), (1, 1), (0, 0)))
    y = w[0] * zp[:, :-2] + w[1] * zp[:, 1:-1] + w[2] * zp[:, 2:]
    return b_gate * y


def pool_mixer(p, w, scale):
    B, S, _ = p.shape
    t = jnp.arange(S)
    pf = p.astype(jnp.float32)
    cs = jnp.concatenate([jnp.zeros((B, 1, POOL_W), jnp.float32), jnp.cumsum(pf, axis=1)], axis=1)
    outs = []
    for gi, win in enumerate(POOL_WINDOWS):
        lo = jnp.clip(t - win // 2, 0, S)
        hi = jnp.clip(t - win // 2 + win, 0, S)
        c = cs[..., gi * POOL_GROUP:(gi + 1) * POOL_GROUP]
        s = jnp.take(c, hi, axis=1) - jnp.take(c, lo, axis=1)
        cnt = (hi - lo).astype(jnp.float32)[:, None]
        outs.append(s / cnt - pf[..., gi * POOL_GROUP:(gi + 1) * POOL_GROUP])
    m = jnp.stack(outs, axis=2).astype(p.dtype)
    y = jnp.einsum('bsgc,gcd->bsgd', m, w).reshape(B, S, POOL_W)
    return y * scale


def gqa_attention(q, k, v, q_norm, k_norm, row, col):
    B, S, _ = q.shape
    q = axial_rope(rms_norm(q.reshape(B, S, GQA_HEADS, HEAD_DIM), q_norm), row, col)
    k = axial_rope(rms_norm(k.reshape(B, S, GQA_KV, HEAD_DIM), k_norm), row, col)
    v = v.reshape(B, S, GQA_KV, HEAD_DIM)
    nb = S // Q_BLOCK
    qb = q.reshape(B, nb, Q_BLOCK, GQA_KV, GQA_GROUP, HEAD_DIM).transpose(1, 0, 2, 3, 4, 5)
    scale = HEAD_DIM ** -0.5

    def block(qi):
        s = jnp.einsum('bqkgd,bskd->bkgqs', qi, k).astype(jnp.float32) * scale
        pr = jax.nn.softmax(s, axis=-1).astype(v.dtype)
        return jnp.einsum('bkgqs,bskd->bqkgd', pr, v)

    o = lax.map(block, qb)
    return o.transpose(1, 0, 2, 3, 4, 5).reshape(B, S, GQA_HEADS * HEAD_DIM)


def diff_attention(q, k, v, q_norm, k_norm, lam_vec, out_norm, lambda_init, pos):
    B, S, _ = q.shape
    q = partial_rope(rms_norm(q.reshape(B, S, DIFF_HEADS, 2, HEAD_DIM), q_norm), pos)
    k = partial_rope(rms_norm(k.reshape(B, S, DIFF_HEADS, 2, HEAD_DIM), k_norm), pos)
    v = v.reshape(B, S, DIFF_HEADS, DIFF_V)
    lv = lam_vec.astype(jnp.float32)
    lam = jnp.exp(jnp.sum(lv[0] * lv[1])) - jnp.exp(jnp.sum(lv[2] * lv[3])) + lambda_init
    nb = S // Q_BLOCK
    qb = q.reshape(B, nb, Q_BLOCK, DIFF_HEADS, 2, HEAD_DIM).transpose(1, 0, 2, 3, 4, 5)
    scale = HEAD_DIM ** -0.5

    def block(qi):
        s = jnp.einsum('bqhcd,bshcd->bhcqs', qi, k).astype(jnp.float32) * scale
        pr = jax.nn.softmax(s, axis=-1)
        a = (pr[:, :, 0] - lam * pr[:, :, 1]).astype(v.dtype)
        return jnp.einsum('bhqs,bshe->bqhe', a, v)

    o = lax.map(block, qb)
    o = o.transpose(1, 0, 2, 3, 4).reshape(B, S, DIFF_HEADS, DIFF_V)
    o = rms_norm(o, out_norm) * (1.0 - lambda_init)
    return o.reshape(B, S, DIFF_HEADS * DIFF_V)


def mixer(h, layer_idx, mix_norm, w_in, b_gate, conv_w, pool_w, pool_scale,
          attn_q_norm, attn_k_norm, diff_q_norm, diff_k_norm, diff_lambda, diff_out_norm,
          w_branch, w_out, row, col, pos):
    B, S, _ = h.shape
    u = rms_norm(h, mix_norm)
    z = u @ w_in
    offs = np.cumsum(IN_SIZES)[:-1].tolist()
    a_x, a_b, a_c, p_in, cq, ck, cv, dq, dk, dv, g = jnp.split(z, offs, axis=-1)
    lambda_init = 0.8 - 0.6 * math.exp(-0.3 * layer_idx)
    branches = (
        short_conv(a_x, a_b, a_c, conv_w),
        pool_mixer(p_in, pool_w, pool_scale),
        gqa_attention(cq, ck, cv, attn_q_norm, attn_k_norm, row, col),
        diff_attention(dq, dk, dv, diff_q_norm, diff_k_norm, diff_lambda, diff_out_norm, lambda_init, pos),
    )
    gates = jax.nn.sigmoid(g + b_gate).reshape(B, S, N_BRANCH, D_MODEL)
    merged = gates[:, :, 0] * (branches[0] @ w_branch[0])
    for n in range(1, N_BRANCH):
        merged = merged + gates[:, :, n] * (branches[n] @ w_branch[n])
    return merged @ w_out


def trunk(x, ffn1_norm, ffn1_w_in, ffn1_w_out, mix_norm, w_in, b_gate, conv_w, pool_w, pool_scale,
          attn_q_norm, attn_k_norm, diff_q_norm, diff_k_norm, diff_lambda, diff_out_norm,
          w_branch, w_out, ffn2_norm, ffn2_w_in, ffn2_w_out):
    S = x.shape[1]
    rows = S // GRID_W
    row = jnp.repeat(jnp.arange(rows), GRID_W)
    col = jnp.tile(jnp.arange(GRID_W), rows)
    pos = jnp.arange(S)
    for i in range(DEPTH):
        x = x + 0.5 * swiglu(x, ffn1_norm[i], ffn1_w_in[i], ffn1_w_out[i])
        x = x + mixer(x, i, mix_norm[i], w_in[i], b_gate[i], conv_w[i], pool_w[i], pool_scale[i],
                      attn_q_norm[i], attn_k_norm[i], diff_q_norm[i], diff_k_norm[i],
                      diff_lambda[i], diff_out_norm[i], w_branch[i], w_out[i], row, col, pos)
        x = x + 0.5 * swiglu(x, ffn2_norm[i], ffn2_w_in[i], ffn2_w_out[i])
    return x


def setup_inputs(seed: int = 0) -> dict:
    key = jax.random.key(seed)
    ks = jax.random.split(key, 24)
    f32 = jnp.float32

    def nrm(k, shape, scale):
        return jax.random.normal(k, shape, f32) * scale

    def gain(k, shape):
        return 1.0 + 0.05 * jax.random.normal(k, shape, f32)

    L, D, F = DEPTH, D_MODEL, D_FF
    return {
        "x_prompt": nrm(ks[0], (BATCH, SEQ, D), 1.0),
        "x_sample": nrm(ks[1], (DEC_BATCH, DEC_SEQ, D), 1.0),
        "ffn1_norm": gain(ks[2], (L, D)),
        "ffn1_w_in": nrm(ks[3], (L, D, 2 * F), D ** -0.5),
        "ffn1_w_out": nrm(ks[4], (L, F, D), F ** -0.5),
        "mix_norm": gain(ks[5], (L, D)),
        "w_in": nrm(ks[6], (L, D, IN_W), D ** -0.5),
        "b_gate": nrm(ks[7], (L, N_BRANCH * D), 0.01),
        "conv_w": nrm(ks[8], (L, 3, CONV_W), 3 ** -0.5),
        "pool_w": nrm(ks[9], (L, 4, POOL_GROUP, POOL_GROUP), POOL_GROUP ** -0.5),
        "pool_scale": 0.5 + 0.05 * jax.random.normal(ks[10], (L, POOL_W), f32),
        "attn_q_norm": gain(ks[11], (L, HEAD_DIM)),
        "attn_k_norm": gain(ks[12], (L, HEAD_DIM)),
        "diff_q_norm": gain(ks[13], (L, HEAD_DIM)),
        "diff_k_norm": gain(ks[14], (L, HEAD_DIM)),
        "diff_lambda": nrm(ks[15], (L, 4, HEAD_DIM), 0.1),
        "diff_out_norm": gain(ks[16], (L, DIFF_V)),
        "w_branch": nrm(ks[17], (L, N_BRANCH, BRANCH_W, D), BRANCH_W ** -0.5),
        "w_out": nrm(ks[18], (L, D, D), D ** -0.5),
        "ffn2_norm": gain(ks[19], (L, D)),
        "ffn2_w_in": nrm(ks[20], (L, D, 2 * F), D ** -0.5),
        "ffn2_w_out": nrm(ks[21], (L, F, D), F ** -0.5),
    }


def reference(x_prompt, x_sample, ffn1_norm, ffn1_w_in, ffn1_w_out, mix_norm, w_in, b_gate,
              conv_w, pool_w, pool_scale, attn_q_norm, attn_k_norm, diff_q_norm, diff_k_norm,
              diff_lambda, diff_out_norm, w_branch, w_out, ffn2_norm, ffn2_w_in, ffn2_w_out):
    y_prompt = trunk(x_prompt, ffn1_norm, ffn1_w_in, ffn1_w_out, mix_norm, w_in, b_gate, conv_w,
                     pool_w, pool_scale, attn_q_norm, attn_k_norm, diff_q_norm, diff_k_norm,
                     diff_lambda, diff_out_norm, w_branch, w_out, ffn2_norm, ffn2_w_in, ffn2_w_out)
    y_sample = trunk(x_sample, ffn1_norm, ffn1_w_in, ffn1_w_out, mix_norm, w_in, b_gate, conv_w,
                     pool_w, pool_scale, attn_q_norm, attn_k_norm, diff_q_norm, diff_k_norm,
                     diff_lambda, diff_out_norm, w_branch, w_out, ffn2_norm, ffn2_w_in, ffn2_w_out)
    return (y_prompt, y_sample)
```

```cpp
#include <hip/hip_runtime.h>
#include <hip/hip_cooperative_groups.h>
#include <cstdio>
namespace cg = cooperative_groups;

typedef unsigned short u16;
using bf16x8 = __attribute__((ext_vector_type(8))) short;
using f32x4  = __attribute__((ext_vector_type(4))) float;
using f32x16 = __attribute__((ext_vector_type(16))) float;
using u32x4  = __attribute__((ext_vector_type(4))) unsigned;
using u32x2  = __attribute__((ext_vector_type(2))) unsigned;
#define DI __device__ __forceinline__

constexpr int TH = 32768;
constexpr int DM = 1024;
constexpr int FF = 2816;
constexpr int NBLK = 256;
constexpr int NTHR = 512;

constexpr long oF1U = 0, oF1D = 5767168, oWCP = 8650752, oWQKV = 10747904, oWG = 13107200,
               oWB = 17301504, oWO = 19398656, oF2U = 20447232, oF2D = 26214400, WLAYER = 29097984;
constexpr long WS_W = 0, WS_XN = 116391936, WS_Y = 183500800, WS_BIG = 317718528, WS_RS = 519045120, WS_BAR = 525336576;
constexpr long BIG_VTG = 150994944, BIG_VTD = BIG_VTG + 8388608;
constexpr long BIG_GS = 67108864, BIG_MS = 100663296;

struct Params { const float* in[22]; float* out; char* ws; };

extern __shared__ __attribute__((aligned(16))) char smem[];

DI int tid_fresh() { int t = threadIdx.x; asm volatile("" : "+v"(t)); return t; }
typedef __bf16 bf16x2_t __attribute__((ext_vector_type(2)));
typedef float f32x2_t __attribute__((ext_vector_type(2)));
DI unsigned pack2(float a, float b) { f32x2_t v = {a, b}; bf16x2_t r = __builtin_convertvector(v, bf16x2_t); return __builtin_bit_cast(unsigned, r); }
DI u16 f2bf(float x) { return (u16)(pack2(x, 0.f) & 0xffffu); }
DI float bf2f(u16 h) { return __uint_as_float(((unsigned)h) << 16); }
DI float bflo(unsigned u) { return __uint_as_float(u << 16); }
DI float bfhi(unsigned u) { return __uint_as_float(u & 0xffff0000u); }


#define XB_TMO      128
#define XB_XCNT(j)  (256  + 64 * (j))
#define XB_XSUB(j)  (1280 + 64 * (j))
#define XB_XGEN(j)  (2304 + 64 * (j))
#define XB_TOP      3328
#define XB_TOPGEN   3392
#define XCD_BAR_WORDS 3456
#define XB_SPIN_CAP (1u << 18)
#define XLAS __attribute__((address_space(3)))
DI unsigned xb_ld(unsigned* p)              { return __hip_atomic_load(p, __ATOMIC_RELAXED, __HIP_MEMORY_SCOPE_AGENT); }
DI unsigned xb_add(unsigned* p, unsigned v) { return __hip_atomic_fetch_add(p, v, __ATOMIC_RELAXED, __HIP_MEMORY_SCOPE_AGENT); }
DI unsigned xb_xcc_id() { return (unsigned)__builtin_amdgcn_s_getreg((3 << 11) | 20) & 0xFu; }
#define XB_SPIN(cond, bar) do { unsigned _sp = 0; while (cond) { __builtin_amdgcn_s_sleep(1); \
    if ((++_sp & 255u) == 0u) { if (xb_ld(&(bar)[XB_TMO])) break; if (_sp > XB_SPIN_CAP) { atomicAdd(&(bar)[XB_TMO], 1u); break; } } } } while (0)
struct XcdBarrier { unsigned* bar; unsigned x; volatile XLAS unsigned* st; };
DI XcdBarrier xcd_barrier_post(unsigned* bar, volatile XLAS unsigned* st) {
  XcdBarrier b; b.bar = bar; b.x = xb_xcc_id(); b.st = st;
  if (threadIdx.x == 0) (void)xb_add(&bar[XB_XCNT(b.x)], 1u);
  return b;
}
DI void xcd_barrier_complete(unsigned* bar, unsigned x, unsigned& nloc, unsigned& nx) {
  const unsigned G = gridDim.x * gridDim.y * gridDim.z;
  unsigned sum, cnt, mine, sp = 0u;
  for (;;) {
    sum = 0u; cnt = 0u; mine = 0u;
#pragma unroll
    for (unsigned j = 0; j < 16; ++j) { const unsigned c = xb_ld(&bar[XB_XCNT(j)]); sum += c; cnt += (c > 0u) ? 1u : 0u; mine = (j == x) ? c : mine; }
    if (sum == G) break;
    __builtin_amdgcn_s_sleep(1);
    if ((++sp & 255u) == 0u) { if (xb_ld(&bar[XB_TMO])) break; if (sp > XB_SPIN_CAP) { atomicAdd(&bar[XB_TMO], 1u); break; } }
  }
  nloc = mine > 0u ? mine : 1u; nx = cnt > 0u ? cnt : 1u;
}
DI void xcd_barrier(const XcdBarrier& b) {
  asm volatile("s_waitcnt vmcnt(0)" ::: "memory");
  __syncthreads();
  if (threadIdx.x == 0) {
    unsigned* bar = b.bar;
    __builtin_amdgcn_s_waitcnt(0);
    unsigned nloc = b.st[0], nx = b.st[1];
    if (nloc == 0u) { xcd_barrier_complete(bar, b.x, nloc, nx); b.st[0] = nloc; b.st[1] = nx; }
    const unsigned old = xb_add(&bar[XB_XSUB(b.x)], 1u);
    const unsigned gen = old / nloc;
    if (old + 1u == (gen + 1u) * nloc) {
      __builtin_amdgcn_fence(__ATOMIC_RELEASE, "agent");
      asm volatile("s_waitcnt vmcnt(0)" ::: "memory");
      const unsigned og = xb_add(&bar[XB_TOP], 1u);
      const unsigned tg = og / nx;
      if (og + 1u == (tg + 1u) * nx) xb_add(&bar[XB_TOPGEN], 1u);
      else XB_SPIN(xb_ld(&bar[XB_TOPGEN]) == tg, bar);
      __builtin_amdgcn_fence(__ATOMIC_ACQUIRE, "agent");
      xb_add(&bar[XB_XGEN(b.x)], 1u);
      asm volatile("s_waitcnt vmcnt(0)" ::: "memory");
    } else {
      XB_SPIN(xb_ld(&bar[XB_XGEN(b.x)]) == gen, bar);
      __builtin_amdgcn_fence(__ATOMIC_ACQUIRE, "agent");
      asm volatile("s_waitcnt vmcnt(0)" ::: "memory");
    }
  }
  __syncthreads();
}

DI void gbar(unsigned* ctr, unsigned target) {
  asm volatile("s_waitcnt vmcnt(0)" ::: "memory");
  __syncthreads();
  if (threadIdx.x == 0) {
    __threadfence();
    __hip_atomic_fetch_add(ctr, 1u, __ATOMIC_RELAXED, __HIP_MEMORY_SCOPE_AGENT);
    while (__hip_atomic_load(ctr, __ATOMIC_RELAXED, __HIP_MEMORY_SCOPE_AGENT) < target) __builtin_amdgcn_s_sleep(1);
    __threadfence();
  }
  __syncthreads();
}

template <bool GAIN>
DI void tr_job_t(const float* __restrict__ src, int ld, int coloff, int swiglu, u16* __restrict__ dst, int K, int N, const float* __restrict__ gain) {
  const int tid = tid_fresh();
  const int total = N * (K >> 6);
  for (int it = blockIdx.x * NTHR + tid; it < total; it += gridDim.x * NTHR) {
    const int n = it % N, kp = it / N;
    int c;
    if (swiglu) { int tl = n >> 8, w = n & 255; c = (w < 128) ? (tl * 128 + w) : (FF + tl * 128 + (w - 128)); }
    else c = coloff + n;
    const float* sp = src + (long)(kp * 64) * ld + c;
    u16* dp = dst + (long)n * K + kp * 64;
    float v[64];
#pragma unroll
    for (int i = 0; i < 64; ++i) v[i] = sp[(long)i * ld];
    if (GAIN) {
#pragma unroll
      for (int i = 0; i < 64; ++i) v[i] *= gain[kp * 64 + i];
    }
#pragma unroll
    for (int i = 0; i < 8; ++i) {
      u32x4 w; w[0] = pack2(v[i*8], v[i*8+1]); w[1] = pack2(v[i*8+2], v[i*8+3]); w[2] = pack2(v[i*8+4], v[i*8+5]); w[3] = pack2(v[i*8+6], v[i*8+7]);
      *(u32x4*)(dp + i * 8) = w;
    }
  }
}
DI void tr_job(const float* __restrict__ src, int ld, int coloff, int swiglu, u16* __restrict__ dst, int K, int N, const float* __restrict__ gain) {
  if (gain) tr_job_t<true>(src, ld, coloff, swiglu, dst, K, N, gain); else tr_job_t<false>(src, ld, coloff, swiglu, dst, K, N, gain);
}

DI void prep_weights(const Params& p) {
  u16* W = (u16*)(p.ws + WS_W);
  for (int l = 0; l < 2; ++l) {
    u16* Wl = W + l * WLAYER;
    tr_job(p.in[3] + (long)l * DM * 2 * FF, 2 * FF, 0, 1, Wl + oF1U, DM, 2 * FF, p.in[2] + l * DM);
    tr_job(p.in[4] + (long)l * FF * DM, DM, 0, 0, Wl + oF1D, FF, DM, nullptr);
    tr_job(p.in[6] + (long)l * DM * 8448, 8448, 0, 0, Wl + oWCP, DM, 2048, p.in[5] + l * DM);
    tr_job(p.in[6] + (long)l * DM * 8448, 8448, 2048, 0, Wl + oWQKV, DM, 2304, p.in[5] + l * DM);
    tr_job(p.in[6] + (long)l * DM * 8448, 8448, 4352, 0, Wl + oWG, DM, 4096, p.in[5] + l * DM);
    for (int n = 0; n < 4; ++n) {
      if (n == 1) continue;
      tr_job(p.in[17] + ((long)l * 4 + n) * 512 * DM, DM, 0, 0, Wl + oWB + (long)n * DM * 512, 512, DM, nullptr);
    }
    tr_job(p.in[18] + (long)l * DM * DM, DM, 0, 0, Wl + oWO, DM, DM, nullptr);
    tr_job(p.in[20] + (long)l * DM * 2 * FF, 2 * FF, 0, 1, Wl + oF2U, DM, 2 * FF, p.in[19] + l * DM);
    tr_job(p.in[21] + (long)l * FF * DM, DM, 0, 0, Wl + oF2D, FF, DM, nullptr);
    {
      const float* pw = p.in[9] + (long)l * 4 * 128 * 128;
      const float* sc = p.in[10] + (long)l * 512;
      const float* wb = p.in[17] + ((long)l * 4 + 1) * 512 * DM;
      u16* dst = Wl + oWB + (long)1 * DM * 512;
      for (int idx = blockIdx.x * NTHR + tid_fresh(); idx < 512 * DM; idx += gridDim.x * NTHR) {
        int d = idx & 1023, kk = idx >> 10, g = kk >> 7, c = kk & 127;
        const float* pwr = pw + ((long)g * 128 + c) * 128;
        float acc = 0.f;
        for (int e = 0; e < 128; ++e) acc += pwr[e] * sc[g * 128 + e] * wb[(long)(g * 128 + e) * DM + d];
        dst[(long)d * 512 + kk] = f2bf(acc);
      }
    }
  }
}

DI void xb_phase(const float* __restrict__ x, u16* __restrict__ xb, float* __restrict__ rs_out) {
  const int tidn = tid_fresh(); const int lane = tidn & 63, wid = tidn >> 6;
  for (int row = blockIdx.x * 8 + wid; row < TH; row += gridDim.x * 8) {
    const float* xr = x + (long)row * DM;
    f32x4 v[4];
    float ss = 0.f;
#pragma unroll
    for (int i = 0; i < 4; ++i) { v[i] = *(const f32x4*)(xr + i * 256 + lane * 4);
      const unsigned w0 = pack2(v[i][0], v[i][1]), w1 = pack2(v[i][2], v[i][3]);
      const float a0 = bflo(w0), a1 = bfhi(w0), a2 = bflo(w1), a3 = bfhi(w1);
      ss += a0*a0 + a1*a1 + a2*a2 + a3*a3; }
#pragma unroll
    for (int o = 32; o > 0; o >>= 1) ss += __shfl_xor(ss, o);
    if (lane < 16) rs_out[lane * TH + row] = (lane == 0) ? ss : 0.f;
#pragma unroll
    for (int i = 0; i < 4; ++i) {
      u32x2 w;
      w[0] = pack2(v[i][0], v[i][1]);
      w[1] = pack2(v[i][2], v[i][3]);
      *(u32x2*)(xb + (long)row * DM + i * 256 + lane * 4) = w;
    }
  }
}
DI void rs_prologue(const float* __restrict__ rs16) {
  float* tab = (float*)(smem + 131072);
  const int t = tid_fresh();
  const int pm = (blockIdx.x & 7) * 16 + ((blockIdx.x >> 3) & 7) + 8 * (t >> 8);
  const int row = pm * 256 + (t & 255);
  float s = 0.f;
#pragma unroll
  for (int k = 0; k < 16; ++k) s += rs16[k * TH + row];
  tab[t] = rsqrtf(s * (1.0f / DM) + 1e-6f);
  __syncthreads();
}
DI float rtab_get(int pm, int rl) { return ((const float*)(smem + 131072))[((pm >> 3) & 1) * 256 + rl]; }

#define LAS __attribute__((address_space(3)))
constexpr int BK = 64, HALF = 128, HTB = HALF * BK * 2;

DI int lds_byte(int r, int c) {
  int st = (r >> 4) * 2 + (c >> 5), rr = r & 15, cc = c & 31, ob = rr * 64 + cc * 2;
  return st * 1024 + (ob ^ (((ob >> 9) & 1) << 5));
}
DI void stage_rc(int b, int& R, int& C) {
  int st = b / 1024, sb = b % 1024, swz = sb ^ (((sb >> 9) & 1) << 5);
  R = (st >> 1) * 16 + swz / 64; C = (st & 1) * 32 + (swz % 64) / 2;
}
DI int perm32(int rho) { const int n = rho >> 4, i = rho & 15; return 8 * (i >> 2) + 4 * n + (i & 3); }

struct Unit { int pm, pn, n; long aoff, boff; };
struct Order {
  int nN, nwg, G, c;
  DI bool next(int i, Unit& u) const {
    const int L = i * G + c; if (L >= nwg) return false;
    const int q = nwg >> 3, xcd = L & 7, off = L >> 3, w = xcd * q + off;
    const int nig = 8 * nN, gid = w / nig, rem = w % nig;
    u.pm = gid * 8 + (rem & 7); u.pn = rem >> 3; u.n = 0; u.aoff = 0; u.boff = 0; return true;
  }
};
struct OneUnit { int pm, pn; DI bool next(int i, Unit& u) const { if (i > 0) return false; u.pm = pm; u.pn = pn; u.n = 0; u.aoff = 0; u.boff = 0; return true; } };
struct GateSteps { int pm, pn; DI bool next(int i, Unit& u) const { if (i > 3) return false; u.pm = pm; u.pn = pn; u.n = i; u.aoff = 0; u.boff = (long)i * DM * DM; return true; } };
struct BranchSteps { int pm, pn; DI bool next(int i, Unit& u) const { if (i > 3) return false; u.pm = pm; u.pn = pn; u.n = i; u.aoff = (long)i * 512; u.boff = (long)i * DM * 512; return true; } };

struct Gemm { const u16* A; const u16* Bt; int lda; int K; };

struct EpiSwiglu {
  u16* out; const float* rs;
  DI void operator()(const f32x4 (&acc)[2][2][4][2], const Unit& u, int wr, int wc, int fr, int fq, int tid) const {
    const int row0 = u.pm * 256 + wr * 64 + fr, col0 = u.pn * 128 + wc * 32 + 8 * fq;
#pragma unroll
    for (int ai = 0; ai < 2; ++ai)
#pragma unroll
      for (int m = 0; m < 4; ++m) {
        u16* rowp = out + (size_t)(row0 + ai * HALF + m * 16) * FF + col0;
        const float rr = rtab_get(u.pm, wr * 64 + fr + ai * HALF + m * 16);
        float v[8];
#pragma unroll
        for (int n = 0; n < 2; ++n) {
          f32x4 a = acc[ai][0][m][n] * rr, b = acc[ai][1][m][n] * rr;
#pragma unroll
          for (int j = 0; j < 4; ++j) v[n * 4 + j] = a[j] * __builtin_amdgcn_rcpf(1.0f + __expf(-a[j])) * b[j];
        }
        u32x4 w; w[0] = pack2(v[0], v[1]); w[1] = pack2(v[2], v[3]); w[2] = pack2(v[4], v[5]); w[3] = pack2(v[6], v[7]);
        *(u32x4*)rowp = w;
      }
  }
};
struct EpiResid {
  float* xd; u16* xb; float* rs; float al; int pad_;
  DI void operator()(const f32x4 (&acc)[2][2][4][2], const Unit& u, int wr, int wc, int fr, int fq, int tid) const {
    const int row0 = u.pm * 256 + wr * 64 + fr, col0 = u.pn * 256 + wc * 32 + 8 * fq;
#pragma unroll
    for (int ai = 0; ai < 2; ++ai) {
      u32x4 xv[4][2];
#pragma unroll
      for (int m = 0; m < 4; ++m) {
        const u16* sp = xb + (size_t)(row0 + ai * HALF + m * 16) * DM + col0;
#pragma unroll
        for (int bj = 0; bj < 2; ++bj) xv[m][bj] = *(const u32x4*)(sp + bj * HALF);
      }
#pragma unroll
      for (int m = 0; m < 4; ++m) {
        const size_t ro = (size_t)(row0 + ai * HALF + m * 16) * DM + col0;
        float ss = 0.f;
#pragma unroll
        for (int bj = 0; bj < 2; ++bj) {
          const u32x4 xw = xv[m][bj];
          f32x4 x0 = {bflo(xw[0]), bfhi(xw[0]), bflo(xw[1]), bfhi(xw[1])}, x1 = {bflo(xw[2]), bfhi(xw[2]), bflo(xw[3]), bfhi(xw[3])};
          f32x4 y0 = x0 + al * acc[ai][bj][m][0], y1 = x1 + al * acc[ai][bj][m][1];
          if (xd) { *(f32x4*)(xd + ro + bj * HALF) = y0; *(f32x4*)(xd + ro + bj * HALF + 4) = y1; }
          u32x4 w; w[0] = pack2(y0[0], y0[1]); w[1] = pack2(y0[2], y0[3]); w[2] = pack2(y1[0], y1[1]); w[3] = pack2(y1[2], y1[3]);
          *(u32x4*)(xb + ro + bj * HALF) = w;
          f32x4 r0 = {bflo(w[0]), bfhi(w[0]), bflo(w[1]), bfhi(w[1])}, r1 = {bflo(w[2]), bfhi(w[2]), bflo(w[3]), bfhi(w[3])};
          ss += r0[0]*r0[0] + r0[1]*r0[1] + r0[2]*r0[2] + r0[3]*r0[3] + r1[0]*r1[0] + r1[1]*r1[1] + r1[2]*r1[2] + r1[3]*r1[3];
        }
        ss += __shfl_xor(ss, 16); ss += __shfl_xor(ss, 32);
        if (fq == 0) rs[(u.pn * 4 + wc) * TH + row0 + ai * HALF + m * 16] = ss;
      }
      __builtin_amdgcn_sched_barrier(0);
    }
  }
};
struct EpiStore {
  u16* out; const float* rs; int ldc; int pad_;
  DI void operator()(const f32x4 (&acc)[2][2][4][2], const Unit& u, int wr, int wc, int fr, int fq, int tid) const {
    const int row0 = u.pm * 256 + wr * 64 + fr, col0 = u.pn * 256 + wc * 32 + 8 * fq;
#pragma unroll
    for (int ai = 0; ai < 2; ++ai)
#pragma unroll
      for (int m = 0; m < 4; ++m) {
        u16* rowp = out + (size_t)(row0 + ai * HALF + m * 16) * ldc + col0;
        const float rr = rtab_get(u.pm, wr * 64 + fr + ai * HALF + m * 16);
#pragma unroll
        for (int bj = 0; bj < 2; ++bj) {
          f32x4 v0 = acc[ai][bj][m][0] * rr, v1 = acc[ai][bj][m][1] * rr;
          u32x4 w; w[0] = pack2(v0[0], v0[1]); w[1] = pack2(v0[2], v0[3]); w[2] = pack2(v1[0], v1[1]); w[3] = pack2(v1[2], v1[3]);
          *(u32x4*)(rowp + bj * HALF) = w;
        }
      }
  }
};
struct EpiStore2 {
  u16* out1; u16* out2;
  DI void operator()(const f32x4 (&acc)[2][2][4][2], const Unit& u, int wr, int wc, int fr, int fq, int tid) const {
    const bool first = u.pn < 8;
    u16* out = first ? out1 : out2;
    const int ldc = first ? 2048 : 2304;
    const int row0 = u.pm * 256 + wr * 64 + fr, col0 = (first ? u.pn : u.pn - 8) * 256 + wc * 32 + 8 * fq;
#pragma unroll
    for (int ai = 0; ai < 2; ++ai)
#pragma unroll
      for (int m = 0; m < 4; ++m) {
        u16* rowp = out + (size_t)(row0 + ai * HALF + m * 16) * ldc + col0;
        const float rr = rtab_get(u.pm, wr * 64 + fr + ai * HALF + m * 16);
#pragma unroll
        for (int bj = 0; bj < 2; ++bj) {
          f32x4 v0 = acc[ai][bj][m][0] * rr, v1 = acc[ai][bj][m][1] * rr;
          u32x4 w; w[0] = pack2(v0[0], v0[1]); w[1] = pack2(v0[2], v0[3]); w[2] = pack2(v1[0], v1[1]); w[3] = pack2(v1[2], v1[3]);
          *(u32x4*)(rowp + bj * HALF) = w;
        }
      }
  }
};
struct EpiGate {
  const float* bias; unsigned* gs;
  DI void operator()(const f32x4 (&acc)[2][2][4][2], const Unit& u, int wr, int wc, int fr, int fq, int tid) const {
    const int col0 = u.pn * 256 + wc * 32 + 8 * fq;
    float rr[2][4];
#pragma unroll
    for (int ai = 0; ai < 2; ++ai)
#pragma unroll
      for (int m = 0; m < 4; ++m) rr[ai][m] = rtab_get(u.pm, wr * 64 + fr + ai * HALF + m * 16);
#pragma unroll
    for (int bj = 0; bj < 2; ++bj) {
      f32x4 b0 = *(const f32x4*)(bias + u.n * DM + col0 + bj * HALF), b1 = *(const f32x4*)(bias + u.n * DM + col0 + bj * HALF + 4);
#pragma unroll
      for (int ai = 0; ai < 2; ++ai)
#pragma unroll
        for (int m = 0; m < 4; ++m)
#pragma unroll
          for (int nn = 0; nn < 2; ++nn) {
            const int idx = ((ai * 2 + bj) * 4 + m) * 2 + nn;
            f32x4 v = acc[ai][bj][m][nn] * rr[ai][m] + (nn ? b1 : b0);
            unsigned qv[4];
#pragma unroll
            for (int j = 0; j < 4; ++j) { const float s = __builtin_amdgcn_rcpf(1.0f + __expf(-v[j])); unsigned qq = (unsigned)(s * 255.0f + 0.5f); qv[j] = qq < 1u ? 1u : qq; }
            gs[(u.n * 32 + idx) * NTHR + tid] = qv[0] | (qv[1] << 8) | (qv[2] << 16) | (qv[3] << 24);
          }
    }
  }
};
struct EpiBranchCarry {
  const unsigned* gs; u16* out;
  DI void operator()(f32x4 (&acc)[2][2][4][2], const Unit& u, int wr, int wc, int fr, int fq, int tid) const {
    const int row0 = u.pm * 256 + wr * 64 + fr, col0 = u.pn * 256 + wc * 32 + 8 * fq;
    const int n = u.n;
#pragma unroll
    for (int ai = 0; ai < 2; ++ai) {
      unsigned g0[16], g1[16];
#pragma unroll
      for (int k = 0; k < 16; ++k) {
        g0[k] = gs[(n * 32 + ai * 16 + k) * NTHR + tid];
        g1[k] = (n < 3) ? gs[((n + 1) * 32 + ai * 16 + k) * NTHR + tid] : 0xffffffffu;
      }
#pragma unroll
      for (int bj = 0; bj < 2; ++bj)
#pragma unroll
        for (int m = 0; m < 4; ++m) {
#pragma unroll
          for (int nn = 0; nn < 2; ++nn) {
            const int k = (bj * 4 + m) * 2 + nn;
            const unsigned a0 = g0[k], a1 = g1[k];
            f32x4 a = acc[ai][bj][m][nn];
            a[0] *= (float)(a0 & 255u) * __builtin_amdgcn_rcpf((float)(a1 & 255u)); a[1] *= (float)((a0 >> 8) & 255u) * __builtin_amdgcn_rcpf((float)((a1 >> 8) & 255u));
            a[2] *= (float)((a0 >> 16) & 255u) * __builtin_amdgcn_rcpf((float)((a1 >> 16) & 255u)); a[3] *= (float)(a0 >> 24) * __builtin_amdgcn_rcpf((float)(a1 >> 24));
            acc[ai][bj][m][nn] = a;
          }
          if (n == 3) {
            f32x4 r0 = acc[ai][bj][m][0], r1 = acc[ai][bj][m][1];
            u32x4 w; w[0] = pack2(r0[0], r0[1]); w[1] = pack2(r0[2], r0[3]); w[2] = pack2(r1[0], r1[1]); w[3] = pack2(r1[2], r1[3]);
            *(u32x4*)(out + (size_t)(row0 + ai * HALF + m * 16) * DM + col0 + bj * HALF) = w;
          }
        }
      __builtin_amdgcn_sched_barrier(0);
    }
  }
};

template <bool KEEP = false, class Epi, class Sched>
DI void gemm_phase(const Gemm g, const Sched S, const Epi E) {
  LAS unsigned char* lds = (LAS unsigned char*)smem;
  const int tid = tid_fresh(), wid = __builtin_amdgcn_readfirstlane(tid >> 6), lane = tid & 63, wr = wid >> 2, wc = wid & 3, fr = lane & 15, fq = lane >> 4;
  const int K = g.K, lda = g.lda, nt = K / BK;
  unsigned voffA[2], voffB[2];
#pragma unroll
  for (int i = 0; i < 2; ++i) { int R, C; stage_rc(tid * 16 + i * 8192, R, C); const int Rb = (R & ~31) + perm32(R & 31);
    voffA[i] = (unsigned)(R * lda + C) * 2u; voffB[i] = (unsigned)(Rb * K + C) * 2u; }
  const size_t kstep = (size_t)(BK * 2);
  const size_t hstepA = (size_t)HALF * lda * 2, hstepB = (size_t)HALF * K * 2;
  const size_t tstepA = 2 * hstepA, tstepB = 2 * hstepB;
  const unsigned ldsw = (unsigned)wid * 1024u;
  const int aoff = lds_byte(wr * 64 + fr, fq * 8), boff = lds_byte(wc * 32 + fr, fq * 8);
#define PG8_SA(b, h) (((b) * 2 + (h)) * HTB)
#define PG8_SB(b, h) ((4 + (b) * 2 + (h)) * HTB)
#define PG8_STAGE(bufoff, gbase, voff) do { _Pragma("unroll") for (int _i = 0; _i < 2; ++_i) \
    __builtin_amdgcn_global_load_lds((const unsigned*)((const char*)(gbase) + (voff)[_i]), (LAS unsigned*)(lds + (bufoff) + ldsw + _i * 8192), 16, 0, 0); } while (0)
#define PG8_LDA(dst, b, h) do { _Pragma("unroll") for (int m = 0; m < 4; ++m) _Pragma("unroll") for (int k = 0; k < 2; ++k) dst[m][k] = *(const LAS bf16x8*)(lds + PG8_SA(b, h) + aoff + m * 2048 + k * 1024); } while (0)
#define PG8_LDB(dst, b, h) do { _Pragma("unroll") for (int n = 0; n < 2; ++n) _Pragma("unroll") for (int k = 0; k < 2; ++k) dst[n][k] = *(const LAS bf16x8*)(lds + PG8_SB(b, h) + boff + n * 2048 + k * 1024); } while (0)
#define PG8_MMA(ai, bj, At, Bt) do { __builtin_amdgcn_s_setprio(1); _Pragma("unroll") for (int m = 0; m < 4; ++m) _Pragma("unroll") for (int n = 0; n < 2; ++n) _Pragma("unroll") for (int k = 0; k < 2; ++k) \
    acc[ai][bj][m][n] = __builtin_amdgcn_mfma_f32_16x16x32_bf16(Bt[n][k], At[m][k], acc[ai][bj][m][n], 0, 0, 0); __builtin_amdgcn_s_setprio(0); } while (0)
#define PG8_WAIT_V(n) asm volatile("s_waitcnt vmcnt(" #n ")" ::: "memory")
#define PG8_WAIT_L(n) asm volatile("s_waitcnt lgkmcnt(" #n ")" ::: "memory")
#define PG8_BAR __builtin_amdgcn_s_barrier()
#define PG8_SCHED __builtin_amdgcn_sched_barrier(0)
  Unit cur, nxt; int ui = 0;
  if (!S.next(0, cur)) return;
  f32x4 acc[2][2][4][2];
#pragma unroll
  for (int a = 0; a < 2; ++a)
#pragma unroll
    for (int b = 0; b < 2; ++b)
#pragma unroll
      for (int m = 0; m < 4; ++m)
#pragma unroll
        for (int n = 0; n < 2; ++n) acc[a][b][m][n] = (f32x4){0.f, 0.f, 0.f, 0.f};
  bf16x8 At[4][2], B0[2][2], B1[2][2];
  const char* cA = (const char*)g.A + cur.aoff * 2 + (size_t)cur.pm * tstepA; const char* cB = (const char*)g.Bt + cur.boff * 2 + (size_t)cur.pn * tstepB;
  PG8_STAGE(PG8_SB(0, 0), cB, voffB); PG8_STAGE(PG8_SA(0, 0), cA, voffA); PG8_STAGE(PG8_SB(0, 1), cB + hstepB, voffB); PG8_STAGE(PG8_SA(0, 1), cA + hstepA, voffA);
  if (wr == 1) PG8_BAR;
  PG8_WAIT_V(4); PG8_BAR;
  PG8_STAGE(PG8_SB(1, 0), cB + kstep, voffB); PG8_STAGE(PG8_SA(1, 0), cA + kstep, voffA); PG8_STAGE(PG8_SB(1, 1), cB + hstepB + kstep, voffB);
  PG8_WAIT_V(6); PG8_BAR;
  for (;;) {
    const bool has_next = S.next(ui + 1, nxt);
    const char* nA = has_next ? (const char*)g.A + nxt.aoff * 2 + (size_t)nxt.pm * tstepA : cA; const char* nB = has_next ? (const char*)g.Bt + nxt.boff * 2 + (size_t)nxt.pn * tstepB : cB;
    for (int t = 0; t < nt; t += 2) {
      const bool last = (t == nt - 2);
      const char* a1 = cA + (size_t)(t + 1) * kstep;
      const char* a2 = last ? nA : cA + (size_t)(t + 2) * kstep; const char* b2 = last ? nB : cB + (size_t)(t + 2) * kstep;
      const char* a3 = a2 + kstep; const char* b3 = b2 + kstep;
      PG8_LDB(B0, 0, 0); PG8_SCHED; PG8_LDA(At, 0, 0); PG8_STAGE(PG8_SA(1, 1), a1 + hstepA, voffA);
      PG8_WAIT_L(8); PG8_BAR; PG8_WAIT_L(0); PG8_MMA(0, 0, At, B0); PG8_BAR; PG8_SCHED;
      PG8_LDB(B1, 0, 1); PG8_STAGE(PG8_SB(0, 0), b2, voffB);
      PG8_BAR; PG8_WAIT_L(0); PG8_MMA(0, 1, At, B1); PG8_BAR;
      PG8_LDA(At, 0, 1); PG8_STAGE(PG8_SA(0, 0), a2, voffA);
      PG8_BAR; PG8_WAIT_L(0); PG8_MMA(1, 0, At, B0); PG8_BAR; PG8_SCHED;
      PG8_STAGE(PG8_SB(0, 1), b2 + hstepB, voffB);
      PG8_WAIT_V(6); PG8_BAR; PG8_MMA(1, 1, At, B1); PG8_BAR;
      PG8_LDB(B0, 1, 0); PG8_SCHED; PG8_LDA(At, 1, 0); PG8_STAGE(PG8_SA(0, 1), a2 + hstepA, voffA);
      PG8_WAIT_L(8); PG8_BAR; PG8_WAIT_L(0); PG8_MMA(0, 0, At, B0); PG8_BAR; PG8_SCHED;
      PG8_LDB(B1, 1, 1); PG8_STAGE(PG8_SB(1, 0), b3, voffB);
      PG8_BAR; PG8_WAIT_L(0); PG8_MMA(0, 1, At, B1); PG8_BAR;
      PG8_LDA(At, 1, 1); PG8_STAGE(PG8_SA(1, 0), a3, voffA);
      PG8_BAR; PG8_WAIT_L(0); PG8_MMA(1, 0, At, B0); PG8_BAR; PG8_SCHED;
      PG8_STAGE(PG8_SB(1, 1), b3 + hstepB, voffB);
      PG8_WAIT_V(6); PG8_BAR; PG8_MMA(1, 1, At, B1); PG8_BAR;
    }
    E(acc, cur, wr, wc, fr, fq, wid * 64 + lane);
    if (!has_next) break;
    if (!KEEP)
#pragma unroll
    for (int a = 0; a < 2; ++a)
#pragma unroll
      for (int b = 0; b < 2; ++b)
#pragma unroll
        for (int m = 0; m < 4; ++m)
#pragma unroll
          for (int n = 0; n < 2; ++n) acc[a][b][m][n] = (f32x4){0.f, 0.f, 0.f, 0.f};
    cur = nxt; cA = nA; cB = nB; ++ui;
  }
  PG8_WAIT_V(0);
  if (wr == 0) PG8_BAR;
  PG8_BAR;
#undef PG8_SA
#undef PG8_SB
#undef PG8_STAGE
#undef PG8_LDA
#undef PG8_LDB
#undef PG8_MMA
#undef PG8_WAIT_V
#undef PG8_WAIT_L
#undef PG8_BAR
#undef PG8_SCHED
}

DI Order make_order(int nN) { Order o; o.nN = nN; o.nwg = 128 * nN; o.G = gridDim.x; o.c = blockIdx.x; return o; }

DI void ld8(const u16* p, float (&o)[8]) {
  u32x4 w = *(const u32x4*)p;
#pragma unroll
  for (int i = 0; i < 4; ++i) { o[2*i] = bflo(w[i]); o[2*i+1] = bfhi(w[i]); }
}
DI void convpool_phase(const u16* __restrict__ z, u16* __restrict__ Y, const float* __restrict__ cw, int S) {
  const int total = (TH / 16) * 128;
  for (int it = blockIdx.x * NTHR + tid_fresh(); it < total; it += gridDim.x * NTHR) {
    const int c = it & 127, t0 = (it >> 7) * 16;
    const int s0 = t0 % S;
    const u16* zs = z + (long)(t0 - s0) * 2048;
    if (c < 64) {
      const int ch = c * 8;
      float w0[8], w1[8], w2[8];
#pragma unroll
      for (int i = 0; i < 8; ++i) { w0[i] = cw[ch + i]; w1[i] = cw[512 + ch + i]; w2[i] = cw[1024 + ch + i]; }
      float zc[18][8];
#pragma unroll
      for (int k = 0; k < 18; ++k) {
        const int s = s0 - 1 + k;
        const bool ok = (s >= 0) && (s < S);
        const int sc_ = ok ? s : s0;
        float a[8], b[8];
        ld8(zs + (long)sc_ * 2048 + ch, a); ld8(zs + (long)sc_ * 2048 + 1024 + ch, b);
#pragma unroll
        for (int i = 0; i < 8; ++i) zc[k][i] = ok ? a[i] * b[i] : 0.f;
      }
#pragma unroll
      for (int k = 0; k < 16; ++k) {
        float g[8];
        ld8(zs + (long)(s0 + k) * 2048 + 512 + ch, g);
        u32x4 o;
#pragma unroll
        for (int i = 0; i < 4; ++i) {
          float y0 = g[2*i] * (w0[2*i] * zc[k][2*i] + w1[2*i] * zc[k+1][2*i] + w2[2*i] * zc[k+2][2*i]);
          float y1 = g[2*i+1] * (w0[2*i+1] * zc[k][2*i+1] + w1[2*i+1] * zc[k+1][2*i+1] + w2[2*i+1] * zc[k+2][2*i+1]);
          o[i] = pack2(y0, y1);
        }
        *(u32x4*)(Y + (long)(t0 + k) * 2048 + ch) = o;
      }
    } else {
      const int ch = (c - 64) * 8;
      const int gi = ch >> 7, win = 2 << gi, hw = win >> 1;
      const u16* zb = zs + 1536 + ch;
      float sum[8];
#pragma unroll
      for (int i = 0; i < 8; ++i) sum[i] = 0.f;
#pragma unroll
      for (int k = 0; k < 16; ++k) {
        const int rr = s0 - hw + k;
        const bool ok = (k < win) && (rr >= 0) && (rr < S);
        float a[8]; ld8(zb + (long)(ok ? rr : s0) * 2048, a);
#pragma unroll
        for (int i = 0; i < 8; ++i) sum[i] += ok ? a[i] : 0.f;
      }
#pragma unroll
      for (int k = 0; k < 16; ++k) {
        const int s = s0 + k;
        int lo = s - hw, hi = lo + win; if (lo < 0) lo = 0; if (hi > S) hi = S;
        const float inv = __builtin_amdgcn_rcpf((float)(hi - lo));
        float pc[8]; ld8(zb + (long)s * 2048, pc);
        u32x4 o;
#pragma unroll
        for (int i = 0; i < 4; ++i) o[i] = pack2(sum[2*i] * inv - pc[2*i], sum[2*i+1] * inv - pc[2*i+1]);
        *(u32x4*)(Y + (long)(t0 + k) * 2048 + 512 + ch) = o;
        const int ra = s - hw + win, rr = s - hw;
        const bool oka = ra < S, okr = rr >= 0;
        float a[8], b[8];
        ld8(zb + (long)(oka ? ra : s) * 2048, a); ld8(zb + (long)(okr ? rr : s) * 2048, b);
#pragma unroll
        for (int i = 0; i < 8; ++i) sum[i] += (oka ? a[i] : 0.f) - (okr ? b[i] : 0.f);
      }
    }
  }
}

DI void qkprep_phase(u16* __restrict__ z, u16* __restrict__ VTg, u16* __restrict__ VTd, int S,
                     const float* __restrict__ gq, const float* __restrict__ gk,
                     const float* __restrict__ dgq, const float* __restrict__ dgk) {
  const int total = TH * 26;
  for (int it = blockIdx.x * NTHR + tid_fresh(); it < total; it += gridDim.x * NTHR) {
    const int t = it / 26, ci = it % 26;
    const int c = ci < 10 ? ci : ci + 2;
    u16* zp = z + (long)t * 2304 + c * 64;
    float v[64];
    float ss = 0.f;
#pragma unroll
    for (int i = 0; i < 8; ++i) {
      u32x4 w = *(const u32x4*)(zp + i * 8);
#pragma unroll
      for (int j = 0; j < 4; ++j) { v[i*8 + 2*j] = bflo(w[j]); v[i*8 + 2*j + 1] = bfhi(w[j]); }
    }
#pragma unroll
    for (int i = 0; i < 64; ++i) ss += v[i] * v[i];
    const float rs = rsqrtf(ss * (1.0f / 64.0f) + 1e-6f);
    const float* g = (c < 8) ? gq : (c < 10) ? gk : (c < 20) ? dgq : dgk;
    const bool isq = (c < 8) || (c >= 12 && c < 20);
    const float qs = isq ? 0.18033688011112042f : 1.0f;
#pragma unroll
    for (int i = 0; i < 64; ++i) v[i] = v[i] * rs * g[i];
    const int s = t % S;
    if (c < 10) {
      const float prow = (float)(s >> 6), pcol = (float)(s & 63);
#pragma unroll
      for (int part = 0; part < 2; ++part) {
        const float pos = part ? pcol : prow;
#pragma unroll
        for (int i = 0; i < 16; ++i) {
          const float fr = exp2f(-(float)i * (13.287712379549449f / 16.0f)) * 0.15915494309189535f;
          float rev = pos * fr; rev -= floorf(rev);
          float sn = __builtin_amdgcn_sinf(rev), cs = __builtin_amdgcn_cosf(rev);
          float x1 = v[part*32 + i], x2 = v[part*32 + 16 + i];
          v[part*32 + i] = x1 * cs - x2 * sn; v[part*32 + 16 + i] = x2 * cs + x1 * sn;
        }
      }
    } else {
      const float pos = (float)s;
#pragma unroll
      for (int i = 0; i < 8; ++i) {
        const float fr = exp2f(-(float)i * (18.931568569324174f / 8.0f)) * 0.15915494309189535f;
        float rev = pos * fr; rev -= floorf(rev);
        float sn = __builtin_amdgcn_sinf(rev), cs = __builtin_amdgcn_cosf(rev);
        float x1 = v[i], x2 = v[8 + i];
        v[i] = x1 * cs - x2 * sn; v[8 + i] = x2 * cs + x1 * sn;
      }
    }
#pragma unroll
    for (int i = 0; i < 8; ++i) {
      u32x4 w;
#pragma unroll
      for (int j = 0; j < 4; ++j) w[j] = pack2(v[i*8 + 2*j] * qs, v[i*8 + 2*j + 1] * qs);
      *(u32x4*)(zp + i * 8) = w;
    }
  }
  u16* tile = (u16*)smem;
  const int tid = tid_fresh();
  for (int tt = blockIdx.x; tt < TH / 64; tt += gridDim.x) {
    const int t0 = tt * 64, seq = t0 / S, s0 = t0 % S;
    {
      const int row = tid >> 3, ch = tid & 7;
#pragma unroll
      for (int cc = 0; cc < 10; ++cc) {
        const int col0 = (cc < 2) ? (640 + cc * 64) : (1792 + (cc - 2) * 64);
        *(u32x4*)(tile + cc * 4608 + row * 72 + ch * 8) = *(const u32x4*)(z + (long)(t0 + row) * 2304 + col0 + ch * 8);
      }
    }
    __syncthreads();
    {
      const int col = tid >> 3, tch = tid & 7;
#pragma unroll
      for (int cc = 0; cc < 10; ++cc) {
        u16* dst;
        if (cc < 2) dst = VTg + ((long)(seq * 2 + cc) * 64) * S + s0;
        else { int j = cc - 2; dst = VTd + ((long)(seq * 4 + (j >> 1)) * 128 + (j & 1) * 64) * S + s0; }
        u32x4 w;
#pragma unroll
        for (int j = 0; j < 4; ++j) w[j] = (unsigned)tile[cc * 4608 + (tch * 8 + 2*j) * 72 + col] | ((unsigned)tile[cc * 4608 + (tch * 8 + 2*j + 1) * 72 + col] << 16);
        *(u32x4*)(dst + (long)col * S + tch * 8) = w;
      }
    }
    __syncthreads();
  }
}

#define MFMA32(a, b, c) __builtin_amdgcn_mfma_f32_32x32x16_bf16((a), (b), (c), 0, 0, 0)

template <int DIFF>
DI void attn_item(const u16* __restrict__ zq, const u16* __restrict__ VT, u16* __restrict__ Y, const int S,
                  const int tok0, const int vtrow0, const int qcol0, const int qcol1, const int kcol0, const int kcol1,
                  const int ycol, const int qb, const float nshift, const float lam,
                  const float* __restrict__ onorm, const float oscale) {
  constexpr int NK = DIFF ? 2 : 1, NQ = DIFF ? 1 : 2, NDV = DIFF ? 4 : 2, DV = NDV * 32, KSTR = 72;
  constexpr int KT = DIFF ? 128 : 64;
  constexpr int VSTR = KT + 8;
  constexpr int KI = KT / 64;
  constexpr int VI = DV * (KT / 8) / NTHR;
  u16* Ks = (u16*)smem;
  u16* Vs = Ks + 2 * NK * KT * KSTR;
  const int tid = tid_fresh(), wid = tid >> 6, lane = tid & 63, r = lane & 31, h = lane >> 5;
  const int rs = (r & 0x13) | ((r & 4) << 1) | ((r & 8) >> 1);
  const int csub = DIFF ? (wid >> 2) : 0;
  const int q = DIFF ? (tok0 + qb * 128 + (wid & 3) * 32 + r) : (tok0 + qb * 256 + wid * 32 + r);
  bf16x8 qf[NQ][4];
#pragma unroll
  for (int t = 0; t < 4; ++t) {
    qf[0][t] = *(const bf16x8*)(zq + (long)q * 2304 + (DIFF ? (csub ? qcol1 : qcol0) : qcol0) + t * 16 + h * 8);
    if (NQ == 2) qf[NQ - 1][t] = *(const bf16x8*)(zq + (long)q * 2304 + qcol1 + t * 16 + h * 8);
  }
  f32x16 o[NQ][NDV];
#pragma unroll
  for (int a = 0; a < NQ; ++a)
#pragma unroll
    for (int d = 0; d < NDV; ++d)
#pragma unroll
      for (int i = 0; i < 16; ++i) o[a][d][i] = 0.f;
  float ls0 = 0.f, ls1 = 0.f;
  f32x16 nsv;
#pragma unroll
  for (int i = 0; i < 16; ++i) nsv[i] = nshift;
  const int lrow = tid >> 3, lch = tid & 7;
  constexpr int VCH = KT / 8;
  const int vrow = tid / VCH, vch = tid % VCH;
  constexpr int VRS = NTHR / VCH;
  u32x4 kreg[NK][KI], vreg[VI];
  const u16* kbase = zq + (long)(tok0 + lrow) * 2304 + lch * 8;
  const u16* vbase = VT + (long)(vtrow0 + vrow) * S + vch * 8;
  const int nkt = S / KT;
#define GLOAD(kt) do { \
    for (int _i = 0; _i < KI; ++_i) { kreg[0][_i] = *(const u32x4*)(kbase + (long)((kt) * KT + 64 * _i) * 2304 + kcol0); \
      if (NK == 2) kreg[NK - 1][_i] = *(const u32x4*)(kbase + (long)((kt) * KT + 64 * _i) * 2304 + kcol1); } \
    for (int _i = 0; _i < VI; ++_i) vreg[_i] = *(const u32x4*)(vbase + (long)(VRS * _i) * S + (kt) * KT); } while (0)
#define LSTORE(st) do { for (int _k = 0; _k < NK; ++_k) for (int _i = 0; _i < KI; ++_i) *(u32x4*)(Ks + (((st) * NK + _k) * KT + lrow + 64 * _i) * KSTR + lch * 8) = kreg[_k][_i]; \
    for (int _i = 0; _i < VI; ++_i) *(u32x4*)(Vs + ((st) * DV + vrow + VRS * _i) * VSTR + vch * 8) = vreg[_i]; } while (0)
  GLOAD(0); LSTORE(0);
#pragma unroll
  for (int a = 0; a < NQ; ++a)
#pragma unroll
    for (int t = 0; t < 4; ++t) asm volatile("" :: "v"(qf[a][t]));
  __syncthreads();
  for (int kt = 0; kt < nkt; ++kt) {
    const int st = kt & 1;
    if (kt + 1 < nkt) GLOAD(kt + 1);
    const u16* Kb = Ks + (st * NK + csub) * KT * KSTR;
    const u16* Vb = Vs + st * DV * VSTR;
#define SB_ __builtin_amdgcn_sched_barrier(0)
#define SOFTMAX_PACK(SC, LS, PF) do { \
      _Pragma("unroll") for (int i = 0; i < 16; ++i) SC[i] = __builtin_amdgcn_exp2f(SC[i]); \
      f32x2_t ps2_ = {SC[0], SC[1]}; \
      _Pragma("unroll") for (int i = 1; i < 8; ++i) { f32x2_t t2_ = {SC[2 * i], SC[2 * i + 1]}; ps2_ += t2_; } \
      LS += ps2_[0] + ps2_[1]; \
      _Pragma("unroll") for (int k2 = 0; k2 < 2; ++k2) { u32x4 pk_; \
        _Pragma("unroll") for (int j = 0; j < 4; ++j) pk_[j] = pack2(SC[8 * k2 + 2 * j], SC[8 * k2 + 2 * j + 1]); \
        PF[k2] = __builtin_bit_cast(bf16x8, pk_); } } while (0)
    if (DIFF) {
#pragma unroll
     for (int kp = 0; kp < KT / 64; ++kp) {
      const int k0 = kp * 64;
      bf16x8 kfA[4], kfB[4];
#pragma unroll
      for (int t = 0; t < 4; ++t) { kfA[t] = *(const bf16x8*)(Kb + (k0 + rs) * KSTR + t * 16 + h * 8); kfB[t] = *(const bf16x8*)(Kb + (k0 + 32 + rs) * KSTR + t * 16 + h * 8); }
      SB_;
      __builtin_amdgcn_s_setprio(1);
      f32x16 scA = MFMA32(kfA[0], qf[0][0], nsv);
#pragma unroll
      for (int t = 1; t < 4; ++t) scA = MFMA32(kfA[t], qf[0][t], scA);
      f32x16 scB = MFMA32(kfB[0], qf[0][0], nsv);
#pragma unroll
      for (int t = 1; t < 4; ++t) scB = MFMA32(kfB[t], qf[0][t], scB);
      __builtin_amdgcn_s_setprio(0);
      SB_;
      bf16x8 vf[2][NDV];
#pragma unroll
      for (int k2 = 0; k2 < 2; ++k2)
#pragma unroll
        for (int d = 0; d < NDV; ++d) vf[k2][d] = *(const bf16x8*)(Vb + (d * 32 + r) * VSTR + k0 + k2 * 16 + h * 8);
      bf16x8 pfA[2], pfB[2];
      SOFTMAX_PACK(scA, ls0, pfA);
      SB_;
      __builtin_amdgcn_s_setprio(1);
#pragma unroll
      for (int k2 = 0; k2 < 2; ++k2)
#pragma unroll
        for (int d = 0; d < NDV; ++d) o[0][d] = MFMA32(vf[k2][d], pfA[k2], o[0][d]);
      __builtin_amdgcn_s_setprio(0);
      SB_;
#pragma unroll
      for (int k2 = 0; k2 < 2; ++k2)
#pragma unroll
        for (int d = 0; d < NDV; ++d) vf[k2][d] = *(const bf16x8*)(Vb + (d * 32 + r) * VSTR + k0 + 32 + k2 * 16 + h * 8);
      SOFTMAX_PACK(scB, ls0, pfB);
      SB_;
      __builtin_amdgcn_s_setprio(1);
#pragma unroll
      for (int k2 = 0; k2 < 2; ++k2)
#pragma unroll
        for (int d = 0; d < NDV; ++d) o[0][d] = MFMA32(vf[k2][d], pfB[k2], o[0][d]);
      __builtin_amdgcn_s_setprio(0);
      SB_;
     }
    } else {
#pragma unroll
      for (int sub = 0; sub < 2; ++sub) {
        bf16x8 kf[4];
        bf16x8 vf[2][NDV];
#pragma unroll
        for (int t = 0; t < 4; ++t) kf[t] = *(const bf16x8*)(Kb + (sub * 32 + rs) * KSTR + t * 16 + h * 8);
#pragma unroll
        for (int k2 = 0; k2 < 2; ++k2)
#pragma unroll
          for (int d = 0; d < NDV; ++d) vf[k2][d] = *(const bf16x8*)(Vb + (d * 32 + r) * VSTR + sub * 32 + k2 * 16 + h * 8);
        SB_;
        __builtin_amdgcn_s_setprio(1);
        f32x16 sc0 = MFMA32(kf[0], qf[0][0], nsv);
#pragma unroll
        for (int t = 1; t < 4; ++t) sc0 = MFMA32(kf[t], qf[0][t], sc0);
        f32x16 sc1 = MFMA32(kf[0], qf[NQ - 1][0], nsv);
#pragma unroll
        for (int t = 1; t < 4; ++t) sc1 = MFMA32(kf[t], qf[NQ - 1][t], sc1);
        __builtin_amdgcn_s_setprio(0);
        SB_;
        bf16x8 pf0[2], pf1[2];
        SOFTMAX_PACK(sc0, ls0, pf0);
        SB_;
        __builtin_amdgcn_s_setprio(1);
#pragma unroll
        for (int k2 = 0; k2 < 2; ++k2)
#pragma unroll
          for (int d = 0; d < NDV; ++d) o[0][d] = MFMA32(vf[k2][d], pf0[k2], o[0][d]);
        __builtin_amdgcn_s_setprio(0);
        SB_;
        SOFTMAX_PACK(sc1, ls1, pf1);
        SB_;
        __builtin_amdgcn_s_setprio(1);
#pragma unroll
        for (int k2 = 0; k2 < 2; ++k2)
#pragma unroll
          for (int d = 0; d < NDV; ++d) o[NQ - 1][d] = MFMA32(vf[k2][d], pf1[k2], o[NQ - 1][d]);
        __builtin_amdgcn_s_setprio(0);
        SB_;
      }
    }
#undef SB_
#undef SOFTMAX_PACK
    if (kt + 1 < nkt) LSTORE(st ^ 1);
    __syncthreads();
  }
#undef GLOAD
#undef LSTORE
  const float l0 = ls0 + __shfl_xor(ls0, 32);
  const float i0 = 1.0f / l0;
  if (!DIFF) {
    const float l1 = ls1 + __shfl_xor(ls1, 32);
    const float i1 = 1.0f / l1;
#pragma unroll
    for (int hh = 0; hh < NQ; ++hh)
#pragma unroll
      for (int d = 0; d < NDV; ++d)
#pragma unroll
        for (int g = 0; g < 4; ++g) {
          const float iv = hh ? i1 : i0;
          u32x2 w;
          w[0] = pack2(o[hh][d][4*g] * iv, o[hh][d][4*g+1] * iv);
          w[1] = pack2(o[hh][d][4*g+2] * iv, o[hh][d][4*g+3] * iv);
          *(u32x2*)(Y + (long)q * 2048 + ycol + hh * 64 + d * 32 + 8 * g + 4 * h) = w;
        }
  } else {
    float* exch = (float*)smem + (wid & 3) * 4096 + lane;
    if (csub == 1) {
#pragma unroll
      for (int d = 0; d < NDV; ++d)
#pragma unroll
        for (int i = 0; i < 16; ++i) exch[(d * 16 + i) * 64] = o[0][d][i] * i0;
    }
    __syncthreads();
    if (csub == 0) {
      float ss = 0.f;
#pragma unroll
      for (int d = 0; d < NDV; ++d)
#pragma unroll
        for (int i = 0; i < 16; ++i) { float v = o[0][d][i] * i0 - lam * exch[(d * 16 + i) * 64]; o[0][d][i] = v; ss += v * v; }
      ss += __shfl_xor(ss, 32);
      const float rn = rsqrtf(ss * (1.0f / 128.0f) + 1e-6f) * oscale;
#pragma unroll
      for (int d = 0; d < NDV; ++d)
#pragma unroll
        for (int g = 0; g < 4; ++g) {
          const int dv = d * 32 + 8 * g + 4 * h;
          f32x4 gn = *(const f32x4*)(onorm + dv);
          u32x2 w;
          w[0] = pack2(o[0][d][4*g] * rn * gn[0], o[0][d][4*g+1] * rn * gn[1]);
          w[1] = pack2(o[0][d][4*g+2] * rn * gn[2], o[0][d][4*g+3] * rn * gn[3]);
          *(u32x2*)(Y + (long)q * 2048 + ycol + dv) = w;
        }
    }
    __syncthreads();
  }
}

DI float wave_max_abs64(const float* g) {
  float v = fabsf(g[tid_fresh() & 63]);
#pragma unroll
  for (int o = 32; o > 0; o >>= 1) v = fmaxf(v, __shfl_xor(v, o));
  return v;
}

DI void attn_phase(const Params& p, int l, int S, const u16* zq, const u16* VTg, const u16* VTd, u16* Y) {
  const float L2E = 1.4426950408889634f;
  const float* gq = p.in[11] + l * 64; const float* gk = p.in[12] + l * 64;
  const float* dgq = p.in[13] + l * 64; const float* dgk = p.in[14] + l * 64;
  const float shift_g = -8.0f * 1.02f * wave_max_abs64(gq) * wave_max_abs64(gk) * L2E;
  const float shift_d = -8.0f * 1.02f * wave_max_abs64(dgq) * wave_max_abs64(dgk) * L2E;
  const float* lv = p.in[15] + l * 256;
  const int ln_ = tid_fresh() & 63;
  float a = lv[ln_] * lv[64 + ln_], b = lv[128 + ln_] * lv[192 + ln_];
#pragma unroll
  for (int o = 32; o > 0; o >>= 1) { a += __shfl_xor(a, o); b += __shfl_xor(b, o); }
  const float lam_init = (l == 0) ? 0.2f : 0.3555090675909693f;
  const float lam = expf(a) - expf(b) + lam_init;
  const float* onorm = p.in[16] + l * 128;
  const int b_ = blockIdx.x, x = b_ & 7, bi = b_ >> 3;
  {
    const int nqb = S / 128;
    for (int rr = 0; rr < 4; ++rr) {
      const int lin = rr * 256 + x * 32 + bi;
      const int combo = lin / nqb, qb = lin % nqb, seq = combo >> 2, hd = combo & 3;
      attn_item<1>(zq, VTd, Y, S, seq * S, (seq * 4 + hd) * 128, 768 + hd * 128, 768 + hd * 128 + 64,
                   1280 + hd * 128, 1280 + hd * 128 + 64, 1536 + hd * 128, qb, shift_d, lam, onorm, 1.0f - lam_init);
    }
  }
  {
    const int nqb = S / 256;
    for (int rr = 0; rr < 2; ++rr) {
      const int lin = rr * 256 + x * 32 + bi;
      const int combo = lin / nqb, qb = lin % nqb, seq = combo >> 2, hd = combo & 3;
      const int kvh = hd >> 1;
      attn_item<0>(zq, VTg, Y, S, seq * S, (seq * 2 + kvh) * 64, hd * 128, hd * 128 + 64,
                   512 + kvh * 64, 512 + kvh * 64, 1024 + hd * 128, qb, shift_g, 0.f, onorm, 1.0f);
    }
  }
}

DI void branch_phase(const u16* XN, const u16* Y, const u16* WG, const u16* WB, const float* bgate,
                     u16* merged, u16* gs_all, float* ms_all, const float* rs) {
  unsigned* gs = (unsigned*)(ms_all + (long)blockIdx.x * 65536);
  Order o = make_order(4);
  for (int i = 0;; ++i) {
    Unit u; if (!o.next(i, u)) break;
    {
      Gemm g1; g1.A = XN; g1.lda = DM; g1.Bt = WG; g1.K = DM;
      GateSteps gsch; gsch.pm = u.pm; gsch.pn = u.pn;
      EpiGate e1; e1.bias = bgate; e1.gs = gs;
      gemm_phase(g1, gsch, e1);
    }
    Gemm g2; g2.A = Y; g2.lda = 2048; g2.Bt = WB; g2.K = 512;
    BranchSteps bs; bs.pm = u.pm; bs.pn = u.pn;
    EpiBranchCarry e2; e2.gs = gs; e2.out = merged;
    gemm_phase<true>(g2, bs, e2);
  }
}

__global__ void __launch_bounds__(NTHR) mega(Params p) {
  cg::grid_group grid = cg::this_grid();
  volatile XLAS unsigned* xst = (volatile XLAS unsigned*)(smem + 147456);
  if (threadIdx.x == 0) { xst[0] = 0u; xst[1] = 0u; xst[2] = 0u; xst[3] = 0u; }
  __syncthreads();
  XcdBarrier xbar = xcd_barrier_post((unsigned*)(p.ws + WS_BAR), xst);
  prep_weights(p);
  grid.sync();

  u16* W = (u16*)(p.ws + WS_W);
  u16* XN = (u16*)(p.ws + WS_XN);
  u16* Y = (u16*)(p.ws + WS_Y);
  char* BIG = p.ws + WS_BIG;
  float* RSa = (float*)(p.ws + WS_RS);
  float* RSb = RSa + 16 * TH;
  float* RSc = RSb + 16 * TH;
  for (int hf = 0; hf < 2; ++hf) {
    const int S = hf == 0 ? 8192 : 2048;
    const float* xin = p.in[hf];
    float* xo = p.out + (long)hf * TH * DM;
    xb_phase(xin, XN, RSc);
    xcd_barrier(xbar);
    for (int l = 0; l < 2; ++l) {
      const u16* Wl = W + (long)l * WLAYER;
      rs_prologue(RSc);
      { Gemm g; g.A = XN; g.lda = DM; g.Bt = Wl + oF1U; g.K = DM; EpiSwiglu e; e.out = (u16*)BIG; e.rs = RSc; gemm_phase(g, make_order(22), e); }
      xcd_barrier(xbar);
      { Gemm g; g.A = (u16*)BIG; g.lda = FF; g.Bt = Wl + oF1D; g.K = FF; EpiResid e; e.xd = nullptr; e.al = 0.5f; e.xb = XN; e.rs = RSa; e.pad_ = 0; gemm_phase(g, make_order(4), e); }
      xcd_barrier(xbar);
      rs_prologue(RSa);
      { Gemm g; g.A = XN; g.lda = DM; g.Bt = Wl + oWCP; g.K = DM; EpiStore2 e; e.out1 = (u16*)xo; e.out2 = (u16*)BIG; gemm_phase(g, make_order(17), e); }
      xcd_barrier(xbar);
      convpool_phase((const u16*)xo, Y, p.in[8] + l * 1536, S);
      qkprep_phase((u16*)BIG, (u16*)(BIG + BIG_VTG), (u16*)(BIG + BIG_VTD), S,
                   p.in[11] + l * 64, p.in[12] + l * 64, p.in[13] + l * 64, p.in[14] + l * 64);
      xcd_barrier(xbar);
      attn_phase(p, l, S, (const u16*)BIG, (const u16*)(BIG + BIG_VTG), (const u16*)(BIG + BIG_VTD), Y);
      xcd_barrier(xbar);
      rs_prologue(RSa);
      branch_phase(XN, Y, Wl + oWG, Wl + oWB, p.in[7] + l * 4096, (u16*)BIG, (u16*)(BIG + BIG_GS), (float*)(BIG + BIG_MS), RSa);
      xcd_barrier(xbar);
      { Gemm g; g.A = (u16*)BIG; g.lda = DM; g.Bt = Wl + oWO; g.K = DM; EpiResid e; e.xd = nullptr; e.al = 1.0f; e.xb = XN; e.rs = RSb; e.pad_ = 0; gemm_phase(g, make_order(4), e); }
      xcd_barrier(xbar);
      rs_prologue(RSb);
      { Gemm g; g.A = XN; g.lda = DM; g.Bt = Wl + oF2U; g.K = DM; EpiSwiglu e; e.out = (u16*)BIG; e.rs = RSb; gemm_phase(g, make_order(22), e); }
      xcd_barrier(xbar);
      { Gemm g; g.A = (u16*)BIG; g.lda = FF; g.Bt = Wl + oF2D; g.K = FF; EpiResid e; e.xd = (l == 1) ? xo : nullptr; e.al = 0.5f; e.xb = XN; e.rs = RSc; e.pad_ = 0; gemm_phase(g, make_order(4), e); }
      xcd_barrier(xbar);
    }
  }
}

extern "C" void kernel_launch(void* const* d_in, const int* in_sizes, int n_in, void* d_out, int out_size,
                              void* d_ws, size_t ws_size, hipStream_t stream) {
  constexpr size_t kLds = 147456 + 16;
  static int inited = 0;
  if (!inited) {
    (void)hipFuncSetAttribute((const void*)mega, hipFuncAttributeMaxDynamicSharedMemorySize, (int)kLds);
    inited = 1;
  }
  Params p{};
  for (int i = 0; i < 22; ++i) p.in[i] = (const float*)d_in[i];
  p.out = (float*)d_out; p.ws = (char*)d_ws;
  (void)hipMemsetAsync((char*)d_ws + WS_BAR, 0, 16384, stream);
  void* args[] = {&p};
  hipError_t e = hipLaunchCooperativeKernel((void*)mega, dim3(NBLK), dim3(NTHR), args, kLds, stream);
  if (e != hipSuccess) fprintf(stderr, "cooperative launch failed: %s\n", hipGetErrorString(e));
}
```

```cpp
#include <hip/hip_runtime.h>
#include <hip/hip_cooperative_groups.h>
#include <cstdio>
namespace cg = cooperative_groups;

typedef unsigned short u16;
using bf16x8 = __attribute__((ext_vector_type(8))) short;
using f32x4  = __attribute__((ext_vector_type(4))) float;
using f32x16 = __attribute__((ext_vector_type(16))) float;
using u32x4  = __attribute__((ext_vector_type(4))) unsigned;
using u32x2  = __attribute__((ext_vector_type(2))) unsigned;
#define DI __device__ __forceinline__

constexpr int TH = 32768;
constexpr int DM = 1024;
constexpr int FF = 2816;
constexpr int NBLK = 256;
constexpr int NTHR = 512;

constexpr long oF1U = 0, oF1D = 5767168, oWCP = 8650752, oWQKV = 10747904, oWG = 13107200,
               oWB = 17301504, oWO = 19398656, oF2U = 20447232, oF2D = 26214400, WLAYER = 29097984;
constexpr long WS_W = 0, WS_XN = 116391936, WS_Y = 183500800, WS_BIG = 317718528, WS_RS = 519045120, WS_BAR = 525336576;
constexpr long BIG_VTG = 150994944, BIG_VTD = BIG_VTG + 8388608;
constexpr long BIG_GS = 67108864, BIG_MS = 100663296;

struct Params { const float* in[22]; float* out; char* ws; };

extern __shared__ __attribute__((aligned(16))) char smem[];

DI int tid_fresh() { int t = threadIdx.x; asm volatile("" : "+v"(t)); return t; }
typedef __bf16 bf16x2_t __attribute__((ext_vector_type(2)));
typedef float f32x2_t __attribute__((ext_vector_type(2)));
DI unsigned pack2(float a, float b) { f32x2_t v = {a, b}; bf16x2_t r = __builtin_convertvector(v, bf16x2_t); return __builtin_bit_cast(unsigned, r); }
DI u16 f2bf(float x) { return (u16)(pack2(x, 0.f) & 0xffffu); }
DI float bf2f(u16 h) { return __uint_as_float(((unsigned)h) << 16); }
DI float bflo(unsigned u) { return __uint_as_float(u << 16); }
DI float bfhi(unsigned u) { return __uint_as_float(u & 0xffff0000u); }


#define XB_TMO      128
#define XB_XCNT(j)  (256  + 64 * (j))
#define XB_XSUB(j)  (1280 + 64 * (j))
#define XB_XGEN(j)  (2304 + 64 * (j))
#define XB_TOP      3328
#define XB_TOPGEN   3392
#define XCD_BAR_WORDS 3456
#define XB_SPIN_CAP (1u << 18)
#define XLAS __attribute__((address_space(3)))
DI unsigned xb_ld(unsigned* p)              { return __hip_atomic_load(p, __ATOMIC_RELAXED, __HIP_MEMORY_SCOPE_AGENT); }
DI unsigned xb_add(unsigned* p, unsigned v) { return __hip_atomic_fetch_add(p, v, __ATOMIC_RELAXED, __HIP_MEMORY_SCOPE_AGENT); }
DI unsigned xb_xcc_id() { return (unsigned)__builtin_amdgcn_s_getreg((3 << 11) | 20) & 0xFu; }
#define XB_SPIN(cond, bar) do { unsigned _sp = 0; while (cond) { __builtin_amdgcn_s_sleep(1); \
    if ((++_sp & 255u) == 0u) { if (xb_ld(&(bar)[XB_TMO])) break; if (_sp > XB_SPIN_CAP) { atomicAdd(&(bar)[XB_TMO], 1u); break; } } } } while (0)
struct XcdBarrier { unsigned* bar; unsigned x; volatile XLAS unsigned* st; };
DI XcdBarrier xcd_barrier_post(unsigned* bar, volatile XLAS unsigned* st) {
  XcdBarrier b; b.bar = bar; b.x = xb_xcc_id(); b.st = st;
  if (threadIdx.x == 0) (void)xb_add(&bar[XB_XCNT(b.x)], 1u);
  return b;
}
DI void xcd_barrier_complete(unsigned* bar, unsigned x, unsigned& nloc, unsigned& nx) {
  const unsigned G = gridDim.x * gridDim.y * gridDim.z;
  unsigned sum, cnt, mine, sp = 0u;
  for (;;) {
    sum = 0u; cnt = 0u; mine = 0u;
#pragma unroll
    for (unsigned j = 0; j < 16; ++j) { const unsigned c = xb_ld(&bar[XB_XCNT(j)]); sum += c; cnt += (c > 0u) ? 1u : 0u; mine = (j == x) ? c : mine; }
    if (sum == G) break;
    __builtin_amdgcn_s_sleep(1);
    if ((++sp & 255u) == 0u) { if (xb_ld(&bar[XB_TMO])) break; if (sp > XB_SPIN_CAP) { atomicAdd(&bar[XB_TMO], 1u); break; } }
  }
  nloc = mine > 0u ? mine : 1u; nx = cnt > 0u ? cnt : 1u;
}
DI void xcd_barrier(const XcdBarrier& b) {
  asm volatile("s_waitcnt vmcnt(0)" ::: "memory");
  __syncthreads();
  if (threadIdx.x == 0) {
    unsigned* bar = b.bar;
    __builtin_amdgcn_s_waitcnt(0);
    unsigned nloc = b.st[0], nx = b.st[1];
    if (nloc == 0u) { xcd_barrier_complete(bar, b.x, nloc, nx); b.st[0] = nloc; b.st[1] = nx; }
    const unsigned old = xb_add(&bar[XB_XSUB(b.x)], 1u);
    const unsigned gen = old / nloc;
    if (old + 1u == (gen + 1u) * nloc) {
      __builtin_amdgcn_fence(__ATOMIC_RELEASE, "agent");
      asm volatile("s_waitcnt vmcnt(0)" ::: "memory");
      const unsigned og = xb_add(&bar[XB_TOP], 1u);
      const unsigned tg = og / nx;
      if (og + 1u == (tg + 1u) * nx) xb_add(&bar[XB_TOPGEN], 1u);
      else XB_SPIN(xb_ld(&bar[XB_TOPGEN]) == tg, bar);
      __builtin_amdgcn_fence(__ATOMIC_ACQUIRE, "agent");
      xb_add(&bar[XB_XGEN(b.x)], 1u);
      asm volatile("s_waitcnt vmcnt(0)" ::: "memory");
    } else {
      XB_SPIN(xb_ld(&bar[XB_XGEN(b.x)]) == gen, bar);
      __builtin_amdgcn_fence(__ATOMIC_ACQUIRE, "agent");
      asm volatile("s_waitcnt vmcnt(0)" ::: "memory");
    }
  }
  __syncthreads();
}

DI void gbar(unsigned* ctr, unsigned target) {
  asm volatile("s_waitcnt vmcnt(0)" ::: "memory");
  __syncthreads();
  if (threadIdx.x == 0) {
    __threadfence();
    __hip_atomic_fetch_add(ctr, 1u, __ATOMIC_RELAXED, __HIP_MEMORY_SCOPE_AGENT);
    while (__hip_atomic_load(ctr, __ATOMIC_RELAXED, __HIP_MEMORY_SCOPE_AGENT) < target) __builtin_amdgcn_s_sleep(1);
    __threadfence();
  }
  __syncthreads();
}

template <bool GAIN>
DI void tr_job_t(const float* __restrict__ src, int ld, int coloff, int swiglu, u16* __restrict__ dst, int K, int N, const float* __restrict__ gain) {
  const int tid = tid_fresh();
  const int total = N * (K >> 6);
  for (int it = blockIdx.x * NTHR + tid; it < total; it += gridDim.x * NTHR) {
    const int n = it % N, kp = it / N;
    int c;
    if (swiglu) { int tl = n >> 8, w = n & 255; c = (w < 128) ? (tl * 128 + w) : (FF + tl * 128 + (w - 128)); }
    else c = coloff + n;
    const float* sp = src + (long)(kp * 64) * ld + c;
    u16* dp = dst + (long)n * K + kp * 64;
    float v[64];
#pragma unroll
    for (int i = 0; i < 64; ++i) v[i] = sp[(long)i * ld];
    if (GAIN) {
#pragma unroll
      for (int i = 0; i < 64; ++i) v[i] *= gain[kp * 64 + i];
    }
#pragma unroll
    for (int i = 0; i < 8; ++i) {
      u32x4 w; w[0] = pack2(v[i*8], v[i*8+1]); w[1] = pack2(v[i*8+2], v[i*8+3]); w[2] = pack2(v[i*8+4], v[i*8+5]); w[3] = pack2(v[i*8+6], v[i*8+7]);
      *(u32x4*)(dp + i * 8) = w;
    }
  }
}
DI void tr_job(const float* __restrict__ src, int ld, int coloff, int swiglu, u16* __restrict__ dst, int K, int N, const float* __restrict__ gain) {
  if (gain) tr_job_t<true>(src, ld, coloff, swiglu, dst, K, N, gain); else tr_job_t<false>(src, ld, coloff, swiglu, dst, K, N, gain);
}

DI void prep_weights(const Params& p) {
  u16* W = (u16*)(p.ws + WS_W);
  for (int l = 0; l < 2; ++l) {
    u16* Wl = W + l * WLAYER;
    tr_job(p.in[3] + (long)l * DM * 2 * FF, 2 * FF, 0, 1, Wl + oF1U, DM, 2 * FF, p.in[2] + l * DM);
    tr_job(p.in[4] + (long)l * FF * DM, DM, 0, 0, Wl + oF1D, FF, DM, nullptr);
    tr_job(p.in[6] + (long)l * DM * 8448, 8448, 0, 0, Wl + oWCP, DM, 2048, p.in[5] + l * DM);
    tr_job(p.in[6] + (long)l * DM * 8448, 8448, 2048, 0, Wl + oWQKV, DM, 2304, p.in[5] + l * DM);
    tr_job(p.in[6] + (long)l * DM * 8448, 8448, 4352, 0, Wl + oWG, DM, 4096, p.in[5] + l * DM);
    for (int n = 0; n < 4; ++n) {
      if (n == 1) continue;
      tr_job(p.in[17] + ((long)l * 4 + n) * 512 * DM, DM, 0, 0, Wl + oWB + (long)n * DM * 512, 512, DM, nullptr);
    }
    tr_job(p.in[18] + (long)l * DM * DM, DM, 0, 0, Wl + oWO, DM, DM, nullptr);
    tr_job(p.in[20] + (long)l * DM * 2 * FF, 2 * FF, 0, 1, Wl + oF2U, DM, 2 * FF, p.in[19] + l * DM);
    tr_job(p.in[21] + (long)l * FF * DM, DM, 0, 0, Wl + oF2D, FF, DM, nullptr);
    {
      const float* pw = p.in[9] + (long)l * 4 * 128 * 128;
      const float* sc = p.in[10] + (long)l * 512;
      const float* wb = p.in[17] + ((long)l * 4 + 1) * 512 * DM;
      u16* dst = Wl + oWB + (long)1 * DM * 512;
      for (int idx = blockIdx.x * NTHR + tid_fresh(); idx < 512 * DM; idx += gridDim.x * NTHR) {
        int d = idx & 1023, kk = idx >> 10, g = kk >> 7, c = kk & 127;
        const float* pwr = pw + ((long)g * 128 + c) * 128;
        float acc = 0.f;
        for (int e = 0; e < 128; ++e) acc += pwr[e] * sc[g * 128 + e] * wb[(long)(g * 128 + e) * DM + d];
        dst[(long)d * 512 + kk] = f2bf(acc);
      }
    }
  }
}

DI void xb_phase(const float* __restrict__ x, u16* __restrict__ xb, float* __restrict__ rs_out) {
  const int tidn = tid_fresh(); const int lane = tidn & 63, wid = tidn >> 6;
  for (int row = blockIdx.x * 8 + wid; row < TH; row += gridDim.x * 8) {
    const float* xr = x + (long)row * DM;
    f32x4 v[4];
    float ss = 0.f;
#pragma unroll
    for (int i = 0; i < 4; ++i) { v[i] = *(const f32x4*)(xr + i * 256 + lane * 4);
      const unsigned w0 = pack2(v[i][0], v[i][1]), w1 = pack2(v[i][2], v[i][3]);
      const float a0 = bflo(w0), a1 = bfhi(w0), a2 = bflo(w1), a3 = bfhi(w1);
      ss += a0*a0 + a1*a1 + a2*a2 + a3*a3; }
#pragma unroll
    for (int o = 32; o > 0; o >>= 1) ss += __shfl_xor(ss, o);
    if (lane < 16) rs_out[lane * TH + row] = (lane == 0) ? ss : 0.f;
#pragma unroll
    for (int i = 0; i < 4; ++i) {
      u32x2 w;
      w[0] = pack2(v[i][0], v[i][1]);
      w[1] = pack2(v[i][2], v[i][3]);
      *(u32x2*)(xb + (long)row * DM + i * 256 + lane * 4) = w;
    }
  }
}
DI void rs_prologue(const float* __restrict__ rs16) {
  float* tab = (float*)(smem + 131072);
  const int t = tid_fresh();
  const int pm = (blockIdx.x & 7) * 16 + ((blockIdx.x >> 3) & 7) + 8 * (t >> 8);
  const int row = pm * 256 + (t & 255);
  float s = 0.f;
#pragma unroll
  for (int k = 0; k < 16; ++k) s += rs16[k * TH + row];
  tab[t] = rsqrtf(s * (1.0f / DM) + 1e-6f);
  __syncthreads();
}
DI float rtab_get(int pm, int rl) { return ((const float*)(smem + 131072))[((pm >> 3) & 1) * 256 + rl]; }

#define LAS __attribute__((address_space(3)))
constexpr int BK = 64, HALF = 128, HTB = HALF * BK * 2;

DI int lds_byte(int r, int c) {
  int st = (r >> 4) * 2 + (c >> 5), rr = r & 15, cc = c & 31, ob = rr * 64 + cc * 2;
  return st * 1024 + (ob ^ (((ob >> 9) & 1) << 5));
}
DI void stage_rc(int b, int& R, int& C) {
  int st = b / 1024, sb = b % 1024, swz = sb ^ (((sb >> 9) & 1) << 5);
  R = (st >> 1) * 16 + swz / 64; C = (st & 1) * 32 + (swz % 64) / 2;
}
DI int perm32(int rho) { const int n = rho >> 4, i = rho & 15; return 8 * (i >> 2) + 4 * n + (i & 3); }

struct Unit { int pm, pn, n; long aoff, boff; };
struct Order {
  int nN, nwg, G, c;
  DI bool next(int i, Unit& u) const {
    const int L = i * G + c; if (L >= nwg) return false;
    const int q = nwg >> 3, xcd = L & 7, off = L >> 3, w = xcd * q + off;
    const int nig = 8 * nN, gid = w / nig, rem = w % nig;
    u.pm = gid * 8 + (rem & 7); u.pn = rem >> 3; u.n = 0; u.aoff = 0; u.boff = 0; return true;
  }
};
struct OneUnit { int pm, pn; DI bool next(int i, Unit& u) const { if (i > 0) return false; u.pm = pm; u.pn = pn; u.n = 0; u.aoff = 0; u.boff = 0; return true; } };
struct GateSteps { int pm, pn; DI bool next(int i, Unit& u) const { if (i > 3) return false; u.pm = pm; u.pn = pn; u.n = i; u.aoff = 0; u.boff = (long)i * DM * DM; return true; } };
struct BranchSteps { int pm, pn; DI bool next(int i, Unit& u) const { if (i > 3) return false; u.pm = pm; u.pn = pn; u.n = i; u.aoff = (long)i * 512; u.boff = (long)i * DM * 512; return true; } };

struct Gemm { const u16* A; const u16* Bt; int lda; int K; };

struct EpiSwiglu {
  u16* out; const float* rs;
  DI void operator()(const f32x4 (&acc)[2][2][4][2], const Unit& u, int wr, int wc, int fr, int fq, int tid) const {
    const int row0 = u.pm * 256 + wr * 64 + fr, col0 = u.pn * 128 + wc * 32 + 8 * fq;
#pragma unroll
    for (int ai = 0; ai < 2; ++ai)
#pragma unroll
      for (int m = 0; m < 4; ++m) {
        u16* rowp = out + (size_t)(row0 + ai * HALF + m * 16) * FF + col0;
        const float rr = rtab_get(u.pm, wr * 64 + fr + ai * HALF + m * 16);
        float v[8];
#pragma unroll
        for (int n = 0; n < 2; ++n) {
          f32x4 a = acc[ai][0][m][n] * rr, b = acc[ai][1][m][n] * rr;
#pragma unroll
          for (int j = 0; j < 4; ++j) v[n * 4 + j] = a[j] * __builtin_amdgcn_rcpf(1.0f + __expf(-a[j])) * b[j];
        }
        u32x4 w; w[0] = pack2(v[0], v[1]); w[1] = pack2(v[2], v[3]); w[2] = pack2(v[4], v[5]); w[3] = pack2(v[6], v[7]);
        *(u32x4*)rowp = w;
      }
  }
};
struct EpiResid {
  float* xd; u16* xb; float* rs; float al; int pad_;
  DI void operator()(const f32x4 (&acc)[2][2][4][2], const Unit& u, int wr, int wc, int fr, int fq, int tid) const {
    const int row0 = u.pm * 256 + wr * 64 + fr, col0 = u.pn * 256 + wc * 32 + 8 * fq;
#pragma unroll
    for (int ai = 0; ai < 2; ++ai) {
      u32x4 xv[4][2];
#pragma unroll
      for (int m = 0; m < 4; ++m) {
        const u16* sp = xb + (size_t)(row0 + ai * HALF + m * 16) * DM + col0;
#pragma unroll
        for (int bj = 0; bj < 2; ++bj) xv[m][bj] = *(const u32x4*)(sp + bj * HALF);
      }
#pragma unroll
      for (int m = 0; m < 4; ++m) {
        const size_t ro = (size_t)(row0 + ai * HALF + m * 16) * DM + col0;
        float ss = 0.f;
#pragma unroll
        for (int bj = 0; bj < 2; ++bj) {
          const u32x4 xw = xv[m][bj];
          f32x4 x0 = {bflo(xw[0]), bfhi(xw[0]), bflo(xw[1]), bfhi(xw[1])}, x1 = {bflo(xw[2]), bfhi(xw[2]), bflo(xw[3]), bfhi(xw[3])};
          f32x4 y0 = x0 + al * acc[ai][bj][m][0], y1 = x1 + al * acc[ai][bj][m][1];
          if (xd) { *(f32x4*)(xd + ro + bj * HALF) = y0; *(f32x4*)(xd + ro + bj * HALF + 4) = y1; }
          u32x4 w; w[0] = pack2(y0[0], y0[1]); w[1] = pack2(y0[2], y0[3]); w[2] = pack2(y1[0], y1[1]); w[3] = pack2(y1[2], y1[3]);
          *(u32x4*)(xb + ro + bj * HALF) = w;
          f32x4 r0 = {bflo(w[0]), bfhi(w[0]), bflo(w[1]), bfhi(w[1])}, r1 = {bflo(w[2]), bfhi(w[2]), bflo(w[3]), bfhi(w[3])};
          ss += r0[0]*r0[0] + r0[1]*r0[1] + r0[2]*r0[2] + r0[3]*r0[3] + r1[0]*r1[0] + r1[1]*r1[1] + r1[2]*r1[2] + r1[3]*r1[3];
        }
        ss += __shfl_xor(ss, 16); ss += __shfl_xor(ss, 32);
        if (fq == 0) rs[(u.pn * 4 + wc) * TH + row0 + ai * HALF + m * 16] = ss;
      }
      __builtin_amdgcn_sched_barrier(0);
    }
  }
};
struct EpiStore {
  u16* out; const float* rs; int ldc; int pad_;
  DI void operator()(const f32x4 (&acc)[2][2][4][2], const Unit& u, int wr, int wc, int fr, int fq, int tid) const {
    const int row0 = u.pm * 256 + wr * 64 + fr, col0 = u.pn * 256 + wc * 32 + 8 * fq;
#pragma unroll
    for (int ai = 0; ai < 2; ++ai)
#pragma unroll
      for (int m = 0; m < 4; ++m) {
        u16* rowp = out + (size_t)(row0 + ai * HALF + m * 16) * ldc + col0;
        const float rr = rtab_get(u.pm, wr * 64 + fr + ai * HALF + m * 16);
#pragma unroll
        for (int bj = 0; bj < 2; ++bj) {
          f32x4 v0 = acc[ai][bj][m][0] * rr, v1 = acc[ai][bj][m][1] * rr;
          u32x4 w; w[0] = pack2(v0[0], v0[1]); w[1] = pack2(v0[2], v0[3]); w[2] = pack2(v1[0], v1[1]); w[3] = pack2(v1[2], v1[3]);
          *(u32x4*)(rowp + bj * HALF) = w;
        }
      }
  }
};
struct EpiGate {
  const float* bias; unsigned* gs;
  DI void operator()(const f32x4 (&acc)[2][2][4][2], const Unit& u, int wr, int wc, int fr, int fq, int tid) const {
    const int col0 = u.pn * 256 + wc * 32 + 8 * fq;
    float rr[2][4];
#pragma unroll
    for (int ai = 0; ai < 2; ++ai)
#pragma unroll
      for (int m = 0; m < 4; ++m) rr[ai][m] = rtab_get(u.pm, wr * 64 + fr + ai * HALF + m * 16);
#pragma unroll
    for (int bj = 0; bj < 2; ++bj) {
      f32x4 b0 = *(const f32x4*)(bias + u.n * DM + col0 + bj * HALF), b1 = *(const f32x4*)(bias + u.n * DM + col0 + bj * HALF + 4);
#pragma unroll
      for (int ai = 0; ai < 2; ++ai)
#pragma unroll
        for (int m = 0; m < 4; ++m)
#pragma unroll
          for (int nn = 0; nn < 2; ++nn) {
            const int idx = ((ai * 2 + bj) * 4 + m) * 2 + nn;
            f32x4 v = acc[ai][bj][m][nn] * rr[ai][m] + (nn ? b1 : b0);
            unsigned qv[4];
#pragma unroll
            for (int j = 0; j < 4; ++j) { const float s = __builtin_amdgcn_rcpf(1.0f + __expf(-v[j])); unsigned qq = (unsigned)(s * 255.0f + 0.5f); qv[j] = qq < 1u ? 1u : qq; }
            gs[(u.n * 32 + idx) * NTHR + tid] = qv[0] | (qv[1] << 8) | (qv[2] << 16) | (qv[3] << 24);
          }
    }
  }
};
struct EpiBranchCarry {
  const unsigned* gs; u16* out;
  DI void operator()(f32x4 (&acc)[2][2][4][2], const Unit& u, int wr, int wc, int fr, int fq, int tid) const {
    const int row0 = u.pm * 256 + wr * 64 + fr, col0 = u.pn * 256 + wc * 32 + 8 * fq;
    const int n = u.n;
#pragma unroll
    for (int ai = 0; ai < 2; ++ai) {
      unsigned g0[16], g1[16];
#pragma unroll
      for (int k = 0; k < 16; ++k) {
        g0[k] = gs[(n * 32 + ai * 16 + k) * NTHR + tid];
        g1[k] = (n < 3) ? gs[((n + 1) * 32 + ai * 16 + k) * NTHR + tid] : 0xffffffffu;
      }
#pragma unroll
      for (int bj = 0; bj < 2; ++bj)
#pragma unroll
        for (int m = 0; m < 4; ++m) {
#pragma unroll
          for (int nn = 0; nn < 2; ++nn) {
            const int k = (bj * 4 + m) * 2 + nn;
            const unsigned a0 = g0[k], a1 = g1[k];
            f32x4 a = acc[ai][bj][m][nn];
            a[0] *= (float)(a0 & 255u) * __builtin_amdgcn_rcpf((float)(a1 & 255u)); a[1] *= (float)((a0 >> 8) & 255u) * __builtin_amdgcn_rcpf((float)((a1 >> 8) & 255u));
            a[2] *= (float)((a0 >> 16) & 255u) * __builtin_amdgcn_rcpf((float)((a1 >> 16) & 255u)); a[3] *= (float)(a0 >> 24) * __builtin_amdgcn_rcpf((float)(a1 >> 24));
            acc[ai][bj][m][nn] = a;
          }
          if (n == 3) {
            f32x4 r0 = acc[ai][bj][m][0], r1 = acc[ai][bj][m][1];
            u32x4 w; w[0] = pack2(r0[0], r0[1]); w[1] = pack2(r0[2], r0[3]); w[2] = pack2(r1[0], r1[1]); w[3] = pack2(r1[2], r1[3]);
            *(u32x4*)(out + (size_t)(row0 + ai * HALF + m * 16) * DM + col0 + bj * HALF) = w;
          }
        }
      __builtin_amdgcn_sched_barrier(0);
    }
  }
};

template <bool KEEP = false, class Epi, class Sched>
DI void gemm_phase(const Gemm g, const Sched S, const Epi E) {
  LAS unsigned char* lds = (LAS unsigned char*)smem;
  const int tid = tid_fresh(), wid = __builtin_amdgcn_readfirstlane(tid >> 6), lane = tid & 63, wr = wid >> 2, wc = wid & 3, fr = lane & 15, fq = lane >> 4;
  const int K = g.K, lda = g.lda, nt = K / BK;
  unsigned voffA[2], voffB[2];
#pragma unroll
  for (int i = 0; i < 2; ++i) { int R, C; stage_rc(tid * 16 + i * 8192, R, C); const int Rb = (R & ~31) + perm32(R & 31);
    voffA[i] = (unsigned)(R * lda + C) * 2u; voffB[i] = (unsigned)(Rb * K + C) * 2u; }
  const size_t kstep = (size_t)(BK * 2);
  const size_t hstepA = (size_t)HALF * lda * 2, hstepB = (size_t)HALF * K * 2;
  const size_t tstepA = 2 * hstepA, tstepB = 2 * hstepB;
  const unsigned ldsw = (unsigned)wid * 1024u;
  const int aoff = lds_byte(wr * 64 + fr, fq * 8), boff = lds_byte(wc * 32 + fr, fq * 8);
#define PG8_SA(b, h) (((b) * 2 + (h)) * HTB)
#define PG8_SB(b, h) ((4 + (b) * 2 + (h)) * HTB)
#define PG8_STAGE(bufoff, gbase, voff) do { _Pragma("unroll") for (int _i = 0; _i < 2; ++_i) \
    __builtin_amdgcn_global_load_lds((const unsigned*)((const char*)(gbase) + (voff)[_i]), (LAS unsigned*)(lds + (bufoff) + ldsw + _i * 8192), 16, 0, 0); } while (0)
#define PG8_LDA(dst, b, h) do { _Pragma("unroll") for (int m = 0; m < 4; ++m) _Pragma("unroll") for (int k = 0; k < 2; ++k) dst[m][k] = *(const LAS bf16x8*)(lds + PG8_SA(b, h) + aoff + m * 2048 + k * 1024); } while (0)
#define PG8_LDB(dst, b, h) do { _Pragma("unroll") for (int n = 0; n < 2; ++n) _Pragma("unroll") for (int k = 0; k < 2; ++k) dst[n][k] = *(const LAS bf16x8*)(lds + PG8_SB(b, h) + boff + n * 2048 + k * 1024); } while (0)
#define PG8_MMA(ai, bj, At, Bt) do { __builtin_amdgcn_s_setprio(1); _Pragma("unroll") for (int m = 0; m < 4; ++m) _Pragma("unroll") for (int n = 0; n < 2; ++n) _Pragma("unroll") for (int k = 0; k < 2; ++k) \
    acc[ai][bj][m][n] = __builtin_amdgcn_mfma_f32_16x16x32_bf16(Bt[n][k], At[m][k], acc[ai][bj][m][n], 0, 0, 0); __builtin_amdgcn_s_setprio(0); } while (0)
#define PG8_WAIT_V(n) asm volatile("s_waitcnt vmcnt(" #n ")" ::: "memory")
#define PG8_WAIT_L(n) asm volatile("s_waitcnt lgkmcnt(" #n ")" ::: "memory")
#define PG8_BAR __builtin_amdgcn_s_barrier()
#define PG8_SCHED __builtin_amdgcn_sched_barrier(0)
  Unit cur, nxt; int ui = 0;
  if (!S.next(0, cur)) return;
  f32x4 acc[2][2][4][2];
#pragma unroll
  for (int a = 0; a < 2; ++a)
#pragma unroll
    for (int b = 0; b < 2; ++b)
#pragma unroll
      for (int m = 0; m < 4; ++m)
#pragma unroll
        for (int n = 0; n < 2; ++n) acc[a][b][m][n] = (f32x4){0.f, 0.f, 0.f, 0.f};
  bf16x8 At[4][2], B0[2][2], B1[2][2];
  const char* cA = (const char*)g.A + cur.aoff * 2 + (size_t)cur.pm * tstepA; const char* cB = (const char*)g.Bt + cur.boff * 2 + (size_t)cur.pn * tstepB;
  PG8_STAGE(PG8_SB(0, 0), cB, voffB); PG8_STAGE(PG8_SA(0, 0), cA, voffA); PG8_STAGE(PG8_SB(0, 1), cB + hstepB, voffB); PG8_STAGE(PG8_SA(0, 1), cA + hstepA, voffA);
  if (wr == 1) PG8_BAR;
  PG8_WAIT_V(4); PG8_BAR;
  PG8_STAGE(PG8_SB(1, 0), cB + kstep, voffB); PG8_STAGE(PG8_SA(1, 0), cA + kstep, voffA); PG8_STAGE(PG8_SB(1, 1), cB + hstepB + kstep, voffB);
  PG8_WAIT_V(6); PG8_BAR;
  for (;;) {
    const bool has_next = S.next(ui + 1, nxt);
    const char* nA = has_next ? (const char*)g.A + nxt.aoff * 2 + (size_t)nxt.pm * tstepA : cA; const char* nB = has_next ? (const char*)g.Bt + nxt.boff * 2 + (size_t)nxt.pn * tstepB : cB;
    for (int t = 0; t < nt; t += 2) {
      const bool last = (t == nt - 2);
      const char* a1 = cA + (size_t)(t + 1) * kstep;
      const char* a2 = last ? nA : cA + (size_t)(t + 2) * kstep; const char* b2 = last ? nB : cB + (size_t)(t + 2) * kstep;
      const char* a3 = a2 + kstep; const char* b3 = b2 + kstep;
      PG8_LDB(B0, 0, 0); PG8_SCHED; PG8_LDA(At, 0, 0); PG8_STAGE(PG8_SA(1, 1), a1 + hstepA, voffA);
      PG8_WAIT_L(8); PG8_BAR; PG8_WAIT_L(0); PG8_MMA(0, 0, At, B0); PG8_BAR; PG8_SCHED;
      PG8_LDB(B1, 0, 1); PG8_STAGE(PG8_SB(0, 0), b2, voffB);
      PG8_BAR; PG8_WAIT_L(0); PG8_MMA(0, 1, At, B1); PG8_BAR;
      PG8_LDA(At, 0, 1); PG8_STAGE(PG8_SA(0, 0), a2, voffA);
      PG8_BAR; PG8_WAIT_L(0); PG8_MMA(1, 0, At, B0); PG8_BAR; PG8_SCHED;
      PG8_STAGE(PG8_SB(0, 1), b2 + hstepB, voffB);
      PG8_WAIT_V(6); PG8_BAR; PG8_MMA(1, 1, At, B1); PG8_BAR;
      PG8_LDB(B0, 1, 0); PG8_SCHED; PG8_LDA(At, 1, 0); PG8_STAGE(PG8_SA(0, 1), a2 + hstepA, voffA);
      PG8_WAIT_L(8); PG8_BAR; PG8_WAIT_L(0); PG8_MMA(0, 0, At, B0); PG8_BAR; PG8_SCHED;
      PG8_LDB(B1, 1, 1); PG8_STAGE(PG8_SB(1, 0), b3, voffB);
      PG8_BAR; PG8_WAIT_L(0); PG8_MMA(0, 1, At, B1); PG8_BAR;
      PG8_LDA(At, 1, 1); PG8_STAGE(PG8_SA(1, 0), a3, voffA);
      PG8_BAR; PG8_WAIT_L(0); PG8_MMA(1, 0, At, B0); PG8_BAR; PG8_SCHED;
      PG8_STAGE(PG8_SB(1, 1), b3 + hstepB, voffB);
      PG8_WAIT_V(6); PG8_BAR; PG8_MMA(1, 1, At, B1); PG8_BAR;
    }
    E(acc, cur, wr, wc, fr, fq, wid * 64 + lane);
    if (!has_next) break;
    if (!KEEP)
#pragma unroll
    for (int a = 0; a < 2; ++a)
#pragma unroll
      for (int b = 0; b < 2; ++b)
#pragma unroll
        for (int m = 0; m < 4; ++m)
#pragma unroll
          for (int n = 0; n < 2; ++n) acc[a][b][m][n] = (f32x4){0.f, 0.f, 0.f, 0.f};
    cur = nxt; cA = nA; cB = nB; ++ui;
  }
  PG8_WAIT_V(0);
  if (wr == 0) PG8_BAR;
  PG8_BAR;
#undef PG8_SA
#undef PG8_SB
#undef PG8_STAGE
#undef PG8_LDA
#undef PG8_LDB
#undef PG8_MMA
#undef PG8_WAIT_V
#undef PG8_WAIT_L
#undef PG8_BAR
#undef PG8_SCHED
}

DI Order make_order(int nN) { Order o; o.nN = nN; o.nwg = 128 * nN; o.G = gridDim.x; o.c = blockIdx.x; return o; }

DI void ld8(const u16* p, float (&o)[8]) {
  u32x4 w = *(const u32x4*)p;
#pragma unroll
  for (int i = 0; i < 4; ++i) { o[2*i] = bflo(w[i]); o[2*i+1] = bfhi(w[i]); }
}
DI void convpool_phase(const u16* __restrict__ z, u16* __restrict__ Y, const float* __restrict__ cw, int S) {
  const int total = (TH / 16) * 128;
  for (int it = blockIdx.x * NTHR + tid_fresh(); it < total; it += gridDim.x * NTHR) {
    const int c = it & 127, t0 = (it >> 7) * 16;
    const int s0 = t0 % S;
    const u16* zs = z + (long)(t0 - s0) * 2048;
    if (c < 64) {
      const int ch = c * 8;
      float w0[8], w1[8], w2[8];
#pragma unroll
      for (int i = 0; i < 8; ++i) { w0[i] = cw[ch + i]; w1[i] = cw[512 + ch + i]; w2[i] = cw[1024 + ch + i]; }
      float zc[18][8];
#pragma unroll
      for (int k = 0; k < 18; ++k) {
        const int s = s0 - 1 + k;
        const bool ok = (s >= 0) && (s < S);
        const int sc_ = ok ? s : s0;
        float a[8], b[8];
        ld8(zs + (long)sc_ * 2048 + ch, a); ld8(zs + (long)sc_ * 2048 + 1024 + ch, b);
#pragma unroll
        for (int i = 0; i < 8; ++i) zc[k][i] = ok ? a[i] * b[i] : 0.f;
      }
#pragma unroll
      for (int k = 0; k < 16; ++k) {
        float g[8];
        ld8(zs + (long)(s0 + k) * 2048 + 512 + ch, g);
        u32x4 o;
#pragma unroll
        for (int i = 0; i < 4; ++i) {
          float y0 = g[2*i] * (w0[2*i] * zc[k][2*i] + w1[2*i] * zc[k+1][2*i] + w2[2*i] * zc[k+2][2*i]);
          float y1 = g[2*i+1] * (w0[2*i+1] * zc[k][2*i+1] + w1[2*i+1] * zc[k+1][2*i+1] + w2[2*i+1] * zc[k+2][2*i+1]);
          o[i] = pack2(y0, y1);
        }
        *(u32x4*)(Y + (long)(t0 + k) * 2048 + ch) = o;
      }
    } else {
      const int ch = (c - 64) * 8;
      const int gi = ch >> 7, win = 2 << gi, hw = win >> 1;
      const u16* zb = zs + 1536 + ch;
      float sum[8];
#pragma unroll
      for (int i = 0; i < 8; ++i) sum[i] = 0.f;
#pragma unroll
      for (int k = 0; k < 16; ++k) {
        const int rr = s0 - hw + k;
        const bool ok = (k < win) && (rr >= 0) && (rr < S);
        float a[8]; ld8(zb + (long)(ok ? rr : s0) * 2048, a);
#pragma unroll
        for (int i = 0; i < 8; ++i) sum[i] += ok ? a[i] : 0.f;
      }
#pragma unroll
      for (int k = 0; k < 16; ++k) {
        const int s = s0 + k;
        int lo = s - hw, hi = lo + win; if (lo < 0) lo = 0; if (hi > S) hi = S;
        const float inv = __builtin_amdgcn_rcpf((float)(hi - lo));
        float pc[8]; ld8(zb + (long)s * 2048, pc);
        u32x4 o;
#pragma unroll
        for (int i = 0; i < 4; ++i) o[i] = pack2(sum[2*i] * inv - pc[2*i], sum[2*i+1] * inv - pc[2*i+1]);
        *(u32x4*)(Y + (long)(t0 + k) * 2048 + 512 + ch) = o;
        const int ra = s - hw + win, rr = s - hw;
        const bool oka = ra < S, okr = rr >= 0;
        float a[8], b[8];
        ld8(zb + (long)(oka ? ra : s) * 2048, a); ld8(zb + (long)(okr ? rr : s) * 2048, b);
#pragma unroll
        for (int i = 0; i < 8; ++i) sum[i] += (oka ? a[i] : 0.f) - (okr ? b[i] : 0.f);
      }
    }
  }
}

DI void qkprep_phase(u16* __restrict__ z, u16* __restrict__ VTg, u16* __restrict__ VTd, int S,
                     const float* __restrict__ gq, const float* __restrict__ gk,
                     const float* __restrict__ dgq, const float* __restrict__ dgk) {
  const int total = TH * 26;
  for (int it = blockIdx.x * NTHR + tid_fresh(); it < total; it += gridDim.x * NTHR) {
    const int t = it / 26, ci = it % 26;
    const int c = ci < 10 ? ci : ci + 2;
    u16* zp = z + (long)t * 2304 + c * 64;
    float v[64];
    float ss = 0.f;
#pragma unroll
    for (int i = 0; i < 8; ++i) {
      u32x4 w = *(const u32x4*)(zp + i * 8);
#pragma unroll
      for (int j = 0; j < 4; ++j) { v[i*8 + 2*j] = bflo(w[j]); v[i*8 + 2*j + 1] = bfhi(w[j]); }
    }
#pragma unroll
    for (int i = 0; i < 64; ++i) ss += v[i] * v[i];
    const float rs = rsqrtf(ss * (1.0f / 64.0f) + 1e-6f);
    const float* g = (c < 8) ? gq : (c < 10) ? gk : (c < 20) ? dgq : dgk;
    const bool isq = (c < 8) || (c >= 12 && c < 20);
    const float qs = isq ? 0.18033688011112042f : 1.0f;
#pragma unroll
    for (int i = 0; i < 64; ++i) v[i] = v[i] * rs * g[i];
    const int s = t % S;
    if (c < 10) {
      const float prow = (float)(s >> 6), pcol = (float)(s & 63);
#pragma unroll
      for (int part = 0; part < 2; ++part) {
        const float pos = part ? pcol : prow;
#pragma unroll
        for (int i = 0; i < 16; ++i) {
          const float fr = exp2f(-(float)i * (13.287712379549449f / 16.0f)) * 0.15915494309189535f;
          float rev = pos * fr; rev -= floorf(rev);
          float sn = __builtin_amdgcn_sinf(rev), cs = __builtin_amdgcn_cosf(rev);
          float x1 = v[part*32 + i], x2 = v[part*32 + 16 + i];
          v[part*32 + i] = x1 * cs - x2 * sn; v[part*32 + 16 + i] = x2 * cs + x1 * sn;
        }
      }
    } else {
      const float pos = (float)s;
#pragma unroll
      for (int i = 0; i < 8; ++i) {
        const float fr = exp2f(-(float)i * (18.931568569324174f / 8.0f)) * 0.15915494309189535f;
        float rev = pos * fr; rev -= floorf(rev);
        float sn = __builtin_amdgcn_sinf(rev), cs = __builtin_amdgcn_cosf(rev);
        float x1 = v[i], x2 = v[8 + i];
        v[i] = x1 * cs - x2 * sn; v[8 + i] = x2 * cs + x1 * sn;
      }
    }
#pragma unroll
    for (int i = 0; i < 8; ++i) {
      u32x4 w;
#pragma unroll
      for (int j = 0; j < 4; ++j) w[j] = pack2(v[i*8 + 2*j] * qs, v[i*8 + 2*j + 1] * qs);
      *(u32x4*)(zp + i * 8) = w;
    }
  }
  u16* tile = (u16*)smem;
  const int tid = tid_fresh();
  for (int tt = blockIdx.x; tt < TH / 64; tt += gridDim.x) {
    const int t0 = tt * 64, seq = t0 / S, s0 = t0 % S;
    {
      const int row = tid >> 3, ch = tid & 7;
#pragma unroll
      for (int cc = 0; cc < 10; ++cc) {
        const int col0 = (cc < 2) ? (640 + cc * 64) : (1792 + (cc - 2) * 64);
        *(u32x4*)(tile + cc * 4608 + row * 72 + ch * 8) = *(const u32x4*)(z + (long)(t0 + row) * 2304 + col0 + ch * 8);
      }
    }
    __syncthreads();
    {
      const int col = tid >> 3, tch = tid & 7;
#pragma unroll
      for (int cc = 0; cc < 10; ++cc) {
        u16* dst;
        if (cc < 2) dst = VTg + ((long)(seq * 2 + cc) * 64) * S + s0;
        else { int j = cc - 2; dst = VTd + ((long)(seq * 4 + (j >> 1)) * 128 + (j & 1) * 64) * S + s0; }
        u32x4 w;
#pragma unroll
        for (int j = 0; j < 4; ++j) w[j] = (unsigned)tile[cc * 4608 + (tch * 8 + 2*j) * 72 + col] | ((unsigned)tile[cc * 4608 + (tch * 8 + 2*j + 1) * 72 + col] << 16);
        *(u32x4*)(dst + (long)col * S + tch * 8) = w;
      }
    }
    __syncthreads();
  }
}

#define MFMA32(a, b, c) __builtin_amdgcn_mfma_f32_32x32x16_bf16((a), (b), (c), 0, 0, 0)

template <int DIFF>
DI void attn_item(const u16* __restrict__ zq, const u16* __restrict__ VT, u16* __restrict__ Y, const int S,
                  const int tok0, const int vtrow0, const int qcol0, const int qcol1, const int kcol0, const int kcol1,
                  const int ycol, const int qb, const float nshift, const float lam,
                  const float* __restrict__ onorm, const float oscale) {
  constexpr int NK = DIFF ? 2 : 1, NQ = DIFF ? 1 : 2, NDV = DIFF ? 4 : 2, DV = NDV * 32, KSTR = 72;
  constexpr int KT = DIFF ? 128 : 64;
  constexpr int VSTR = KT + 8;
  constexpr int KI = KT / 64;
  constexpr int VI = DV * (KT / 8) / NTHR;
  u16* Ks = (u16*)smem;
  u16* Vs = Ks + 2 * NK * KT * KSTR;
  const int tid = tid_fresh(), wid = tid >> 6, lane = tid & 63, r = lane & 31, h = lane >> 5;
  const int rs = (r & 0x13) | ((r & 4) << 1) | ((r & 8) >> 1);
  const int csub = DIFF ? (wid >> 2) : 0;
  const int q = DIFF ? (tok0 + qb * 128 + (wid & 3) * 32 + r) : (tok0 + qb * 256 + wid * 32 + r);
  bf16x8 qf[NQ][4];
#pragma unroll
  for (int t = 0; t < 4; ++t) {
    qf[0][t] = *(const bf16x8*)(zq + (long)q * 2304 + (DIFF ? (csub ? qcol1 : qcol0) : qcol0) + t * 16 + h * 8);
    if (NQ == 2) qf[NQ - 1][t] = *(const bf16x8*)(zq + (long)q * 2304 + qcol1 + t * 16 + h * 8);
  }
  f32x16 o[NQ][NDV];
#pragma unroll
  for (int a = 0; a < NQ; ++a)
#pragma unroll
    for (int d = 0; d < NDV; ++d)
#pragma unroll
      for (int i = 0; i < 16; ++i) o[a][d][i] = 0.f;
  float ls0 = 0.f, ls1 = 0.f;
  f32x16 nsv;
#pragma unroll
  for (int i = 0; i < 16; ++i) nsv[i] = nshift;
  const int lrow = tid >> 3, lch = tid & 7;
  constexpr int VCH = KT / 8;
  const int vrow = tid / VCH, vch = tid % VCH;
  constexpr int VRS = NTHR / VCH;
  u32x4 kreg[NK][KI], vreg[VI];
  const u16* kbase = zq + (long)(tok0 + lrow) * 2304 + lch * 8;
  const u16* vbase = VT + (long)(vtrow0 + vrow) * S + vch * 8;
  const int nkt = S / KT;
#define GLOAD(kt) do { \
    for (int _i = 0; _i < KI; ++_i) { kreg[0][_i] = *(const u32x4*)(kbase + (long)((kt) * KT + 64 * _i) * 2304 + kcol0); \
      if (NK == 2) kreg[NK - 1][_i] = *(const u32x4*)(kbase + (long)((kt) * KT + 64 * _i) * 2304 + kcol1); } \
    for (int _i = 0; _i < VI; ++_i) vreg[_i] = *(const u32x4*)(vbase + (long)(VRS * _i) * S + (kt) * KT); } while (0)
#define LSTORE(st) do { for (int _k = 0; _k < NK; ++_k) for (int _i = 0; _i < KI; ++_i) *(u32x4*)(Ks + (((st) * NK + _k) * KT + lrow + 64 * _i) * KSTR + lch * 8) = kreg[_k][_i]; \
    for (int _i = 0; _i < VI; ++_i) *(u32x4*)(Vs + ((st) * DV + vrow + VRS * _i) * VSTR + vch * 8) = vreg[_i]; } while (0)
  GLOAD(0); LSTORE(0);
#pragma unroll
  for (int a = 0; a < NQ; ++a)
#pragma unroll
    for (int t = 0; t < 4; ++t) asm volatile("" :: "v"(qf[a][t]));
  __syncthreads();
  for (int kt = 0; kt < nkt; ++kt) {
    const int st = kt & 1;
    if (kt + 1 < nkt) GLOAD(kt + 1);
    const u16* Kb = Ks + (st * NK + csub) * KT * KSTR;
    const u16* Vb = Vs + st * DV * VSTR;
#define SB_ __builtin_amdgcn_sched_barrier(0)
#define SOFTMAX_PACK(SC, LS, PF) do { \
      _Pragma("unroll") for (int i = 0; i < 16; ++i) SC[i] = __builtin_amdgcn_exp2f(SC[i]); \
      f32x2_t ps2_ = {SC[0], SC[1]}; \
      _Pragma("unroll") for (int i = 1; i < 8; ++i) { f32x2_t t2_ = {SC[2 * i], SC[2 * i + 1]}; ps2_ += t2_; } \
      LS += ps2_[0] + ps2_[1]; \
      _Pragma("unroll") for (int k2 = 0; k2 < 2; ++k2) { u32x4 pk_; \
        _Pragma("unroll") for (int j = 0; j < 4; ++j) pk_[j] = pack2(SC[8 * k2 + 2 * j], SC[8 * k2 + 2 * j + 1]); \
        PF[k2] = __builtin_bit_cast(bf16x8, pk_); } } while (0)
    if (DIFF) {
#pragma unroll
     for (int kp = 0; kp < KT / 64; ++kp) {
      const int k0 = kp * 64;
      bf16x8 kfA[4], kfB[4];
#pragma unroll
      for (int t = 0; t < 4; ++t) { kfA[t] = *(const bf16x8*)(Kb + (k0 + rs) * KSTR + t * 16 + h * 8); kfB[t] = *(const bf16x8*)(Kb + (k0 + 32 + rs) * KSTR + t * 16 + h * 8); }
      SB_;
      __builtin_amdgcn_s_setprio(1);
      f32x16 scA = MFMA32(kfA[0], qf[0][0], nsv);
#pragma unroll
      for (int t = 1; t < 4; ++t) scA = MFMA32(kfA[t], qf[0][t], scA);
      f32x16 scB = MFMA32(kfB[0], qf[0][0], nsv);
#pragma unroll
      for (int t = 1; t < 4; ++t) scB = MFMA32(kfB[t], qf[0][t], scB);
      __builtin_amdgcn_s_setprio(0);
      SB_;
      bf16x8 vf[2][NDV];
#pragma unroll
      for (int k2 = 0; k2 < 2; ++k2)
#pragma unroll
        for (int d = 0; d < NDV; ++d) vf[k2][d] = *(const bf16x8*)(Vb + (d * 32 + r) * VSTR + k0 + k2 * 16 + h * 8);
      bf16x8 pfA[2], pfB[2];
      SOFTMAX_PACK(scA, ls0, pfA);
      SB_;
      __builtin_amdgcn_s_setprio(1);
#pragma unroll
      for (int k2 = 0; k2 < 2; ++k2)
#pragma unroll
        for (int d = 0; d < NDV; ++d) o[0][d] = MFMA32(vf[k2][d], pfA[k2], o[0][d]);
      __builtin_amdgcn_s_setprio(0);
      SB_;
#pragma unroll
      for (int k2 = 0; k2 < 2; ++k2)
#pragma unroll
        for (int d = 0; d < NDV; ++d) vf[k2][d] = *(const bf16x8*)(Vb + (d * 32 + r) * VSTR + k0 + 32 + k2 * 16 + h * 8);
      SOFTMAX_PACK(scB, ls0, pfB);
      SB_;
      __builtin_amdgcn_s_setprio(1);
#pragma unroll
      for (int k2 = 0; k2 < 2; ++k2)
#pragma unroll
        for (int d = 0; d < NDV; ++d) o[0][d] = MFMA32(vf[k2][d], pfB[k2], o[0][d]);
      __builtin_amdgcn_s_setprio(0);
      SB_;
     }
    } else {
#pragma unroll
      for (int sub = 0; sub < 2; ++sub) {
        bf16x8 kf[4];
        bf16x8 vf[2][NDV];
#pragma unroll
        for (int t = 0; t < 4; ++t) kf[t] = *(const bf16x8*)(Kb + (sub * 32 + rs) * KSTR + t * 16 + h * 8);
#pragma unroll
        for (int k2 = 0; k2 < 2; ++k2)
#pragma unroll
          for (int d = 0; d < NDV; ++d) vf[k2][d] = *(const bf16x8*)(Vb + (d * 32 + r) * VSTR + sub * 32 + k2 * 16 + h * 8);
        SB_;
        __builtin_amdgcn_s_setprio(1);
        f32x16 sc0 = MFMA32(kf[0], qf[0][0], nsv);
#pragma unroll
        for (int t = 1; t < 4; ++t) sc0 = MFMA32(kf[t], qf[0][t], sc0);
        f32x16 sc1 = MFMA32(kf[0], qf[NQ - 1][0], nsv);
#pragma unroll
        for (int t = 1; t < 4; ++t) sc1 = MFMA32(kf[t], qf[NQ - 1][t], sc1);
        __builtin_amdgcn_s_setprio(0);
        SB_;
        bf16x8 pf0[2], pf1[2];
        SOFTMAX_PACK(sc0, ls0, pf0);
        SB_;
        __builtin_amdgcn_s_setprio(1);
#pragma unroll
        for (int k2 = 0; k2 < 2; ++k2)
#pragma unroll
          for (int d = 0; d < NDV; ++d) o[0][d] = MFMA32(vf[k2][d], pf0[k2], o[0][d]);
        __builtin_amdgcn_s_setprio(0);
        SB_;
        SOFTMAX_PACK(sc1, ls1, pf1);
        SB_;
        __builtin_amdgcn_s_setprio(1);
#pragma unroll
        for (int k2 = 0; k2 < 2; ++k2)
#pragma unroll
          for (int d = 0; d < NDV; ++d) o[NQ - 1][d] = MFMA32(vf[k2][d], pf1[k2], o[NQ - 1][d]);
        __builtin_amdgcn_s_setprio(0);
        SB_;
      }
    }
#undef SB_
#undef SOFTMAX_PACK
    if (kt + 1 < nkt) LSTORE(st ^ 1);
    __syncthreads();
  }
#undef GLOAD
#undef LSTORE
  const float l0 = ls0 + __shfl_xor(ls0, 32);
  const float i0 = 1.0f / l0;
  if (!DIFF) {
    const float l1 = ls1 + __shfl_xor(ls1, 32);
    const float i1 = 1.0f / l1;
#pragma unroll
    for (int hh = 0; hh < NQ; ++hh)
#pragma unroll
      for (int d = 0; d < NDV; ++d)
#pragma unroll
        for (int g = 0; g < 4; ++g) {
          const float iv = hh ? i1 : i0;
          u32x2 w;
          w[0] = pack2(o[hh][d][4*g] * iv, o[hh][d][4*g+1] * iv);
          w[1] = pack2(o[hh][d][4*g+2] * iv, o[hh][d][4*g+3] * iv);
          *(u32x2*)(Y + (long)q * 2048 + ycol + hh * 64 + d * 32 + 8 * g + 4 * h) = w;
        }
  } else {
    float* exch = (float*)smem + (wid & 3) * 4096 + lane;
    if (csub == 1) {
#pragma unroll
      for (int d = 0; d < NDV; ++d)
#pragma unroll
        for (int i = 0; i < 16; ++i) exch[(d * 16 + i) * 64] = o[0][d][i] * i0;
    }
    __syncthreads();
    if (csub == 0) {
      float ss = 0.f;
#pragma unroll
      for (int d = 0; d < NDV; ++d)
#pragma unroll
        for (int i = 0; i < 16; ++i) { float v = o[0][d][i] * i0 - lam * exch[(d * 16 + i) * 64]; o[0][d][i] = v; ss += v * v; }
      ss += __shfl_xor(ss, 32);
      const float rn = rsqrtf(ss * (1.0f / 128.0f) + 1e-6f) * oscale;
#pragma unroll
      for (int d = 0; d < NDV; ++d)
#pragma unroll
        for (int g = 0; g < 4; ++g) {
          const int dv = d * 32 + 8 * g + 4 * h;
          f32x4 gn = *(const f32x4*)(onorm + dv);
          u32x2 w;
          w[0] = pack2(o[0][d][4*g] * rn * gn[0], o[0][d][4*g+1] * rn * gn[1]);
          w[1] = pack2(o[0][d][4*g+2] * rn * gn[2], o[0][d][4*g+3] * rn * gn[3]);
          *(u32x2*)(Y + (long)q * 2048 + ycol + dv) = w;
        }
    }
    __syncthreads();
  }
}

DI float wave_max_abs64(const float* g) {
  float v = fabsf(g[tid_fresh() & 63]);
#pragma unroll
  for (int o = 32; o > 0; o >>= 1) v = fmaxf(v, __shfl_xor(v, o));
  return v;
}

DI void attn_phase(const Params& p, int l, int S, const u16* zq, const u16* VTg, const u16* VTd, u16* Y) {
  const float L2E = 1.4426950408889634f;
  const float* gq = p.in[11] + l * 64; const float* gk = p.in[12] + l * 64;
  const float* dgq = p.in[13] + l * 64; const float* dgk = p.in[14] + l * 64;
  const float shift_g = -8.0f * 1.02f * wave_max_abs64(gq) * wave_max_abs64(gk) * L2E;
  const float shift_d = -8.0f * 1.02f * wave_max_abs64(dgq) * wave_max_abs64(dgk) * L2E;
  const float* lv = p.in[15] + l * 256;
  const int ln_ = tid_fresh() & 63;
  float a = lv[ln_] * lv[64 + ln_], b = lv[128 + ln_] * lv[192 + ln_];
#pragma unroll
  for (int o = 32; o > 0; o >>= 1) { a += __shfl_xor(a, o); b += __shfl_xor(b, o); }
  const float lam_init = (l == 0) ? 0.2f : 0.3555090675909693f;
  const float lam = expf(a) - expf(b) + lam_init;
  const float* onorm = p.in[16] + l * 128;
  const int b_ = blockIdx.x, x = b_ & 7, bi = b_ >> 3;
  {
    const int nqb = S / 128;
    for (int rr = 0; rr < 4; ++rr) {
      const int lin = rr * 256 + x * 32 + bi;
      const int combo = lin / nqb, qb = lin % nqb, seq = combo >> 2, hd = combo & 3;
      attn_item<1>(zq, VTd, Y, S, seq * S, (seq * 4 + hd) * 128, 768 + hd * 128, 768 + hd * 128 + 64,
                   1280 + hd * 128, 1280 + hd * 128 + 64, 1536 + hd * 128, qb, shift_d, lam, onorm, 1.0f - lam_init);
    }
  }
  {
    const int nqb = S / 256;
    for (int rr = 0; rr < 2; ++rr) {
      const int lin = rr * 256 + x * 32 + bi;
      const int combo = lin / nqb, qb = lin % nqb, seq = combo >> 2, hd = combo & 3;
      const int kvh = hd >> 1;
      attn_item<0>(zq, VTg, Y, S, seq * S, (seq * 2 + kvh) * 64, hd * 128, hd * 128 + 64,
                   512 + kvh * 64, 512 + kvh * 64, 1024 + hd * 128, qb, shift_g, 0.f, onorm, 1.0f);
    }
  }
}

DI void branch_phase(const u16* XN, const u16* Y, const u16* WG, const u16* WB, const float* bgate,
                     u16* merged, u16* gs_all, float* ms_all, const float* rs) {
  unsigned* gs = (unsigned*)(ms_all + (long)blockIdx.x * 65536);
  Order o = make_order(4);
  for (int i = 0;; ++i) {
    Unit u; if (!o.next(i, u)) break;
    {
      Gemm g1; g1.A = XN; g1.lda = DM; g1.Bt = WG; g1.K = DM;
      GateSteps gsch; gsch.pm = u.pm; gsch.pn = u.pn;
      EpiGate e1; e1.bias = bgate; e1.gs = gs;
      gemm_phase(g1, gsch, e1);
    }
    Gemm g2; g2.A = Y; g2.lda = 2048; g2.Bt = WB; g2.K = 512;
    BranchSteps bs; bs.pm = u.pm; bs.pn = u.pn;
    EpiBranchCarry e2; e2.gs = gs; e2.out = merged;
    gemm_phase<true>(g2, bs, e2);
  }
}

__global__ void __launch_bounds__(NTHR) mega(Params p) {
  cg::grid_group grid = cg::this_grid();
  volatile XLAS unsigned* xst = (volatile XLAS unsigned*)(smem + 147456);
  if (threadIdx.x == 0) { xst[0] = 0u; xst[1] = 0u; xst[2] = 0u; xst[3] = 0u; }
  __syncthreads();
  if (blockIdx.x == 0) { unsigned* bw = (unsigned*)(p.ws + WS_BAR); for (int i = threadIdx.x; i < XCD_BAR_WORDS; i += NTHR) bw[i] = 0u; }
  prep_weights(p);
  grid.sync();
  XcdBarrier xbar = xcd_barrier_post((unsigned*)(p.ws + WS_BAR), xst);

  u16* W = (u16*)(p.ws + WS_W);
  u16* XN = (u16*)(p.ws + WS_XN);
  u16* Y = (u16*)(p.ws + WS_Y);
  char* BIG = p.ws + WS_BIG;
  float* RSa = (float*)(p.ws + WS_RS);
  float* RSb = RSa + 16 * TH;
  float* RSc = RSb + 16 * TH;
  for (int hf = 0; hf < 2; ++hf) {
    const int S = hf == 0 ? 8192 : 2048;
    const float* xin = p.in[hf];
    float* xo = p.out + (long)hf * TH * DM;
    xb_phase(xin, XN, RSc);
    xcd_barrier(xbar);
    for (int l = 0; l < 2; ++l) {
      const u16* Wl = W + (long)l * WLAYER;
      rs_prologue(RSc);
      { Gemm g; g.A = XN; g.lda = DM; g.Bt = Wl + oF1U; g.K = DM; EpiSwiglu e; e.out = (u16*)BIG; e.rs = RSc; gemm_phase(g, make_order(22), e); }
      xcd_barrier(xbar);
      { Gemm g; g.A = (u16*)BIG; g.lda = FF; g.Bt = Wl + oF1D; g.K = FF; EpiResid e; e.xd = nullptr; e.al = 0.5f; e.xb = XN; e.rs = RSa; e.pad_ = 0; gemm_phase(g, make_order(4), e); }
      xcd_barrier(xbar);
      rs_prologue(RSa);
      { Gemm g; g.A = XN; g.lda = DM; g.Bt = Wl + oWCP; g.K = DM; EpiStore e; e.out = (u16*)BIG; e.ldc = 2048; e.rs = RSa; gemm_phase(g, make_order(8), e); }
      xcd_barrier(xbar);
      convpool_phase((const u16*)BIG, Y, p.in[8] + l * 1536, S);
      xcd_barrier(xbar);
      rs_prologue(RSa);
      { Gemm g; g.A = XN; g.lda = DM; g.Bt = Wl + oWQKV; g.K = DM; EpiStore e; e.out = (u16*)BIG; e.ldc = 2304; e.rs = RSa; gemm_phase(g, make_order(9), e); }
      xcd_barrier(xbar);
      qkprep_phase((u16*)BIG, (u16*)(BIG + BIG_VTG), (u16*)(BIG + BIG_VTD), S,
                   p.in[11] + l * 64, p.in[12] + l * 64, p.in[13] + l * 64, p.in[14] + l * 64);
      xcd_barrier(xbar);
      attn_phase(p, l, S, (const u16*)BIG, (const u16*)(BIG + BIG_VTG), (const u16*)(BIG + BIG_VTD), Y);
      xcd_barrier(xbar);
      rs_prologue(RSa);
      branch_phase(XN, Y, Wl + oWG, Wl + oWB, p.in[7] + l * 4096, (u16*)BIG, (u16*)(BIG + BIG_GS), (float*)(BIG + BIG_MS), RSa);
      xcd_barrier(xbar);
      { Gemm g; g.A = (u16*)BIG; g.lda = DM; g.Bt = Wl + oWO; g.K = DM; EpiResid e; e.xd = nullptr; e.al = 1.0f; e.xb = XN; e.rs = RSb; e.pad_ = 0; gemm_phase(g, make_order(4), e); }
      xcd_barrier(xbar);
      rs_prologue(RSb);
      { Gemm g; g.A = XN; g.lda = DM; g.Bt = Wl + oF2U; g.K = DM; EpiSwiglu e; e.out = (u16*)BIG; e.rs = RSb; gemm_phase(g, make_order(22), e); }
      xcd_barrier(xbar);
      { Gemm g; g.A = (u16*)BIG; g.lda = FF; g.Bt = Wl + oF2D; g.K = FF; EpiResid e; e.xd = (l == 1) ? xo : nullptr; e.al = 0.5f; e.xb = XN; e.rs = RSc; e.pad_ = 0; gemm_phase(g, make_order(4), e); }
      xcd_barrier(xbar);
    }
  }
}

extern "C" void kernel_launch(void* const* d_in, const int* in_sizes, int n_in, void* d_out, int out_size,
                              void* d_ws, size_t ws_size, hipStream_t stream) {
  constexpr size_t kLds = 147456 + 16;
  static int inited = 0;
  if (!inited) {
    (void)hipFuncSetAttribute((const void*)mega, hipFuncAttributeMaxDynamicSharedMemorySize, (int)kLds);
    inited = 1;
  }
  Params p{};
  for (int i = 0; i < 22; ++i) p.in[i] = (const float*)d_in[i];
  p.out = (float*)d_out; p.ws = (char*)d_ws;
  void* args[] = {&p};
  hipError_t e = hipLaunchCooperativeKernel((void*)mega, dim3(NBLK), dim3(NTHR), args, kLds, stream);
  if (e != hipSuccess) fprintf(stderr, "cooperative launch failed: %s\n", hipGetErrorString(e));
}
```

```cpp
#include <hip/hip_runtime.h>
#include <hip/hip_cooperative_groups.h>
#include <cstdio>
namespace cg = cooperative_groups;

typedef unsigned short u16;
using bf16x8 = __attribute__((ext_vector_type(8))) short;
using f32x4  = __attribute__((ext_vector_type(4))) float;
using f32x16 = __attribute__((ext_vector_type(16))) float;
using u32x4  = __attribute__((ext_vector_type(4))) unsigned;
using u32x2  = __attribute__((ext_vector_type(2))) unsigned;
#define DI __device__ __forceinline__

constexpr int TH = 32768;
constexpr int DM = 1024;
constexpr int FF = 2816;
constexpr int NBLK = 256;
constexpr int NTHR = 512;

constexpr long oF1U = 0, oF1D = 5767168, oWCP = 8650752, oWQKV = 10747904, oWG = 13107200,
               oWB = 17301504, oWO = 19398656, oF2U = 20447232, oF2D = 26214400, WLAYER = 29097984;
constexpr long WS_W = 0, WS_XN = 116391936, WS_Y = 183500800, WS_BIG = 317718528, WS_RS = 519045120, WS_BAR = 525336576;
constexpr long BIG_VTG = 150994944, BIG_VTD = BIG_VTG + 8388608;
constexpr long BIG_GS = 67108864, BIG_MS = 100663296;

struct Params { const float* in[22]; float* out; char* ws; };

extern __shared__ __attribute__((aligned(16))) char smem[];

DI int tid_fresh() { int t = threadIdx.x; asm volatile("" : "+v"(t)); return t; }
typedef __bf16 bf16x2_t __attribute__((ext_vector_type(2)));
typedef float f32x2_t __attribute__((ext_vector_type(2)));
DI unsigned pack2(float a, float b) { f32x2_t v = {a, b}; bf16x2_t r = __builtin_convertvector(v, bf16x2_t); return __builtin_bit_cast(unsigned, r); }
DI u16 f2bf(float x) { return (u16)(pack2(x, 0.f) & 0xffffu); }
DI float bf2f(u16 h) { return __uint_as_float(((unsigned)h) << 16); }
DI float bflo(unsigned u) { return __uint_as_float(u << 16); }
DI float bfhi(unsigned u) { return __uint_as_float(u & 0xffff0000u); }


#define XB_TMO      128
#define XB_XCNT(j)  (256  + 64 * (j))
#define XB_XSUB(j)  (1280 + 64 * (j))
#define XB_XGEN(j)  (2304 + 64 * (j))
#define XB_TOP      3328
#define XB_TOPGEN   3392
#define XCD_BAR_WORDS 3456
#define XB_SPIN_CAP (1u << 18)
#define XLAS __attribute__((address_space(3)))
DI unsigned xb_ld(unsigned* p)              { return __hip_atomic_load(p, __ATOMIC_RELAXED, __HIP_MEMORY_SCOPE_AGENT); }
DI unsigned xb_add(unsigned* p, unsigned v) { return __hip_atomic_fetch_add(p, v, __ATOMIC_RELAXED, __HIP_MEMORY_SCOPE_AGENT); }
DI unsigned xb_xcc_id() { return (unsigned)__builtin_amdgcn_s_getreg((3 << 11) | 20) & 0xFu; }
#define XB_SPIN(cond, bar) do { unsigned _sp = 0; while (cond) { __builtin_amdgcn_s_sleep(1); \
    if ((++_sp & 255u) == 0u) { if (xb_ld(&(bar)[XB_TMO])) break; if (_sp > XB_SPIN_CAP) { atomicAdd(&(bar)[XB_TMO], 1u); break; } } } } while (0)
struct XcdBarrier { unsigned* bar; unsigned x; volatile XLAS unsigned* st; };
DI XcdBarrier xcd_barrier_post(unsigned* bar, volatile XLAS unsigned* st) {
  XcdBarrier b; b.bar = bar; b.x = xb_xcc_id(); b.st = st;
  if (threadIdx.x == 0) (void)xb_add(&bar[XB_XCNT(b.x)], 1u);
  return b;
}
DI void xcd_barrier_complete(unsigned* bar, unsigned x, unsigned& nloc, unsigned& nx) {
  const unsigned G = gridDim.x * gridDim.y * gridDim.z;
  unsigned sum, cnt, mine, sp = 0u;
  for (;;) {
    sum = 0u; cnt = 0u; mine = 0u;
#pragma unroll
    for (unsigned j = 0; j < 16; ++j) { const unsigned c = xb_ld(&bar[XB_XCNT(j)]); sum += c; cnt += (c > 0u) ? 1u : 0u; mine = (j == x) ? c : mine; }
    if (sum == G) break;
    __builtin_amdgcn_s_sleep(1);
    if ((++sp & 255u) == 0u) { if (xb_ld(&bar[XB_TMO])) break; if (sp > XB_SPIN_CAP) { atomicAdd(&bar[XB_TMO], 1u); break; } }
  }
  nloc = mine > 0u ? mine : 1u; nx = cnt > 0u ? cnt : 1u;
}
DI void xcd_barrier(const XcdBarrier& b) {
  asm volatile("s_waitcnt vmcnt(0)" ::: "memory");
  __syncthreads();
  if (threadIdx.x == 0) {
    unsigned* bar = b.bar;
    __builtin_amdgcn_s_waitcnt(0);
    unsigned nloc = b.st[0], nx = b.st[1];
    if (nloc == 0u) { xcd_barrier_complete(bar, b.x, nloc, nx); b.st[0] = nloc; b.st[1] = nx; }
    const unsigned old = xb_add(&bar[XB_XSUB(b.x)], 1u);
    const unsigned gen = old / nloc;
    if (old + 1u == (gen + 1u) * nloc) {
      __builtin_amdgcn_fence(__ATOMIC_RELEASE, "agent");
      asm volatile("s_waitcnt vmcnt(0)" ::: "memory");
      const unsigned og = xb_add(&bar[XB_TOP], 1u);
      const unsigned tg = og / nx;
      if (og + 1u == (tg + 1u) * nx) xb_add(&bar[XB_TOPGEN], 1u);
      else XB_SPIN(xb_ld(&bar[XB_TOPGEN]) == tg, bar);
      __builtin_amdgcn_fence(__ATOMIC_ACQUIRE, "agent");
      xb_add(&bar[XB_XGEN(b.x)], 1u);
      asm volatile("s_waitcnt vmcnt(0)" ::: "memory");
    } else {
      XB_SPIN(xb_ld(&bar[XB_XGEN(b.x)]) == gen, bar);
      __builtin_amdgcn_fence(__ATOMIC_ACQUIRE, "agent");
      asm volatile("s_waitcnt vmcnt(0)" ::: "memory");
    }
  }
  __syncthreads();
}

DI void gbar(unsigned* ctr, unsigned target) {
  asm volatile("s_waitcnt vmcnt(0)" ::: "memory");
  __syncthreads();
  if (threadIdx.x == 0) {
    __threadfence();
    __hip_atomic_fetch_add(ctr, 1u, __ATOMIC_RELAXED, __HIP_MEMORY_SCOPE_AGENT);
    while (__hip_atomic_load(ctr, __ATOMIC_RELAXED, __HIP_MEMORY_SCOPE_AGENT) < target) __builtin_amdgcn_s_sleep(1);
    __threadfence();
  }
  __syncthreads();
}

template <bool GAIN>
DI void tr_job_t(const float* __restrict__ src, int ld, int coloff, int swiglu, u16* __restrict__ dst, int K, int N, const float* __restrict__ gain) {
  const int tid = tid_fresh();
  const int total = N * (K >> 6);
  for (int it = blockIdx.x * NTHR + tid; it < total; it += gridDim.x * NTHR) {
    const int n = it % N, kp = it / N;
    int c;
    if (swiglu) { int tl = n >> 8, w = n & 255; c = (w < 128) ? (tl * 128 + w) : (FF + tl * 128 + (w - 128)); }
    else c = coloff + n;
    const float* sp = src + (long)(kp * 64) * ld + c;
    u16* dp = dst + (long)n * K + kp * 64;
    float v[64];
#pragma unroll
    for (int i = 0; i < 64; ++i) v[i] = sp[(long)i * ld];
    if (GAIN) {
#pragma unroll
      for (int i = 0; i < 64; ++i) v[i] *= gain[kp * 64 + i];
    }
#pragma unroll
    for (int i = 0; i < 8; ++i) {
      u32x4 w; w[0] = pack2(v[i*8], v[i*8+1]); w[1] = pack2(v[i*8+2], v[i*8+3]); w[2] = pack2(v[i*8+4], v[i*8+5]); w[3] = pack2(v[i*8+6], v[i*8+7]);
      *(u32x4*)(dp + i * 8) = w;
    }
  }
}
DI void tr_job(const float* __restrict__ src, int ld, int coloff, int swiglu, u16* __restrict__ dst, int K, int N, const float* __restrict__ gain) {
  if (gain) tr_job_t<true>(src, ld, coloff, swiglu, dst, K, N, gain); else tr_job_t<false>(src, ld, coloff, swiglu, dst, K, N, gain);
}

DI void prep_weights(const Params& p) {
  u16* W = (u16*)(p.ws + WS_W);
  for (int l = 0; l < 2; ++l) {
    u16* Wl = W + l * WLAYER;
    tr_job(p.in[3] + (long)l * DM * 2 * FF, 2 * FF, 0, 1, Wl + oF1U, DM, 2 * FF, p.in[2] + l * DM);
    tr_job(p.in[4] + (long)l * FF * DM, DM, 0, 0, Wl + oF1D, FF, DM, nullptr);
    tr_job(p.in[6] + (long)l * DM * 8448, 8448, 0, 0, Wl + oWCP, DM, 2048, p.in[5] + l * DM);
    tr_job(p.in[6] + (long)l * DM * 8448, 8448, 2048, 0, Wl + oWQKV, DM, 2304, p.in[5] + l * DM);
    tr_job(p.in[6] + (long)l * DM * 8448, 8448, 4352, 0, Wl + oWG, DM, 4096, p.in[5] + l * DM);
    for (int n = 0; n < 4; ++n) {
      if (n == 1) continue;
      tr_job(p.in[17] + ((long)l * 4 + n) * 512 * DM, DM, 0, 0, Wl + oWB + (long)n * DM * 512, 512, DM, nullptr);
    }
    tr_job(p.in[18] + (long)l * DM * DM, DM, 0, 0, Wl + oWO, DM, DM, nullptr);
    tr_job(p.in[20] + (long)l * DM * 2 * FF, 2 * FF, 0, 1, Wl + oF2U, DM, 2 * FF, p.in[19] + l * DM);
    tr_job(p.in[21] + (long)l * FF * DM, DM, 0, 0, Wl + oF2D, FF, DM, nullptr);
    {
      const float* pw = p.in[9] + (long)l * 4 * 128 * 128;
      const float* sc = p.in[10] + (long)l * 512;
      const float* wb = p.in[17] + ((long)l * 4 + 1) * 512 * DM;
      u16* dst = Wl + oWB + (long)1 * DM * 512;
      for (int idx = blockIdx.x * NTHR + tid_fresh(); idx < 512 * DM; idx += gridDim.x * NTHR) {
        int d = idx & 1023, kk = idx >> 10, g = kk >> 7, c = kk & 127;
        const float* pwr = pw + ((long)g * 128 + c) * 128;
        float acc = 0.f;
        for (int e = 0; e < 128; ++e) acc += pwr[e] * sc[g * 128 + e] * wb[(long)(g * 128 + e) * DM + d];
        dst[(long)d * 512 + kk] = f2bf(acc);
      }
    }
  }
}

DI void xb_phase(const float* __restrict__ x, u16* __restrict__ xb, float* __restrict__ rs_out) {
  const int tidn = tid_fresh(); const int lane = tidn & 63, wid = tidn >> 6;
  for (int row = blockIdx.x * 8 + wid; row < TH; row += gridDim.x * 8) {
    const float* xr = x + (long)row * DM;
    f32x4 v[4];
    float ss = 0.f;
#pragma unroll
    for (int i = 0; i < 4; ++i) { v[i] = *(const f32x4*)(xr + i * 256 + lane * 4);
      const unsigned w0 = pack2(v[i][0], v[i][1]), w1 = pack2(v[i][2], v[i][3]);
      const float a0 = bflo(w0), a1 = bfhi(w0), a2 = bflo(w1), a3 = bfhi(w1);
      ss += a0*a0 + a1*a1 + a2*a2 + a3*a3; }
#pragma unroll
    for (int o = 32; o > 0; o >>= 1) ss += __shfl_xor(ss, o);
    if (lane < 16) rs_out[lane * TH + row] = (lane == 0) ? ss : 0.f;
#pragma unroll
    for (int i = 0; i < 4; ++i) {
      u32x2 w;
      w[0] = pack2(v[i][0], v[i][1]);
      w[1] = pack2(v[i][2], v[i][3]);
      *(u32x2*)(xb + (long)row * DM + i * 256 + lane * 4) = w;
    }
  }
}
DI void rs_prologue(const float* __restrict__ rs16) {
  float* tab = (float*)(smem + 131072);
  const int t = tid_fresh();
  const int pm = (blockIdx.x & 7) * 16 + ((blockIdx.x >> 3) & 7) + 8 * (t >> 8);
  const int row = pm * 256 + (t & 255);
  float s = 0.f;
#pragma unroll
  for (int k = 0; k < 16; ++k) s += rs16[k * TH + row];
  tab[t] = rsqrtf(s * (1.0f / DM) + 1e-6f);
  __syncthreads();
}
DI float rtab_get(int pm, int rl) { return ((const float*)(smem + 131072))[((pm >> 3) & 1) * 256 + rl]; }

#define LAS __attribute__((address_space(3)))
constexpr int BK = 64, HALF = 128, HTB = HALF * BK * 2;

DI int lds_byte(int r, int c) {
  int st = (r >> 4) * 2 + (c >> 5), rr = r & 15, cc = c & 31, ob = rr * 64 + cc * 2;
  return st * 1024 + (ob ^ (((ob >> 9) & 1) << 5));
}
DI void stage_rc(int b, int& R, int& C) {
  int st = b / 1024, sb = b % 1024, swz = sb ^ (((sb >> 9) & 1) << 5);
  R = (st >> 1) * 16 + swz / 64; C = (st & 1) * 32 + (swz % 64) / 2;
}
DI int perm32(int rho) { const int n = rho >> 4, i = rho & 15; return 8 * (i >> 2) + 4 * n + (i & 3); }

struct Unit { int pm, pn, n; long aoff, boff; };
struct Order {
  int nN, nwg, G, c;
  DI bool next(int i, Unit& u) const {
    const int L = i * G + c; if (L >= nwg) return false;
    const int q = nwg >> 3, xcd = L & 7, off = L >> 3, w = xcd * q + off;
    const int nig = 8 * nN, gid = w / nig, rem = w % nig;
    u.pm = gid * 8 + (rem & 7); u.pn = rem >> 3; u.n = 0; u.aoff = 0; u.boff = 0; return true;
  }
};
struct OneUnit { int pm, pn; DI bool next(int i, Unit& u) const { if (i > 0) return false; u.pm = pm; u.pn = pn; u.n = 0; u.aoff = 0; u.boff = 0; return true; } };
struct GateSteps { int pm, pn; DI bool next(int i, Unit& u) const { if (i > 3) return false; u.pm = pm; u.pn = pn; u.n = i; u.aoff = 0; u.boff = (long)i * DM * DM; return true; } };
struct BranchSteps { int pm, pn; DI bool next(int i, Unit& u) const { if (i > 3) return false; u.pm = pm; u.pn = pn; u.n = i; u.aoff = (long)i * 512; u.boff = (long)i * DM * 512; return true; } };

struct Gemm { const u16* A; const u16* Bt; int lda; int K; };

struct EpiSwiglu {
  u16* out; const float* rs;
  DI void operator()(const f32x4 (&acc)[2][2][4][2], const Unit& u, int wr, int wc, int fr, int fq, int tid) const {
    const int row0 = u.pm * 256 + wr * 64 + fr, col0 = u.pn * 128 + wc * 32 + 8 * fq;
#pragma unroll
    for (int ai = 0; ai < 2; ++ai)
#pragma unroll
      for (int m = 0; m < 4; ++m) {
        u16* rowp = out + (size_t)(row0 + ai * HALF + m * 16) * FF + col0;
        const float rr = rtab_get(u.pm, wr * 64 + fr + ai * HALF + m * 16);
        float v[8];
#pragma unroll
        for (int n = 0; n < 2; ++n) {
          f32x4 a = acc[ai][0][m][n] * rr, b = acc[ai][1][m][n] * rr;
#pragma unroll
          for (int j = 0; j < 4; ++j) v[n * 4 + j] = a[j] * __builtin_amdgcn_rcpf(1.0f + __expf(-a[j])) * b[j];
        }
        u32x4 w; w[0] = pack2(v[0], v[1]); w[1] = pack2(v[2], v[3]); w[2] = pack2(v[4], v[5]); w[3] = pack2(v[6], v[7]);
        *(u32x4*)rowp = w;
      }
  }
};
struct EpiResid {
  float* xd; u16* xb; float* rs; float al; int pad_;
  DI void operator()(const f32x4 (&acc)[2][2][4][2], const Unit& u, int wr, int wc, int fr, int fq, int tid) const {
    const int row0 = u.pm * 256 + wr * 64 + fr, col0 = u.pn * 256 + wc * 32 + 8 * fq;
#pragma unroll
    for (int ai = 0; ai < 2; ++ai) {
      u32x4 xv[4][2];
#pragma unroll
      for (int m = 0; m < 4; ++m) {
        const u16* sp = xb + (size_t)(row0 + ai * HALF + m * 16) * DM + col0;
#pragma unroll
        for (int bj = 0; bj < 2; ++bj) xv[m][bj] = *(const u32x4*)(sp + bj * HALF);
      }
#pragma unroll
      for (int m = 0; m < 4; ++m) {
        const size_t ro = (size_t)(row0 + ai * HALF + m * 16) * DM + col0;
        float ss = 0.f;
#pragma unroll
        for (int bj = 0; bj < 2; ++bj) {
          const u32x4 xw = xv[m][bj];
          f32x4 x0 = {bflo(xw[0]), bfhi(xw[0]), bflo(xw[1]), bfhi(xw[1])}, x1 = {bflo(xw[2]), bfhi(xw[2]), bflo(xw[3]), bfhi(xw[3])};
          f32x4 y0 = x0 + al * acc[ai][bj][m][0], y1 = x1 + al * acc[ai][bj][m][1];
          if (xd) { *(f32x4*)(xd + ro + bj * HALF) = y0; *(f32x4*)(xd + ro + bj * HALF + 4) = y1; }
          u32x4 w; w[0] = pack2(y0[0], y0[1]); w[1] = pack2(y0[2], y0[3]); w[2] = pack2(y1[0], y1[1]); w[3] = pack2(y1[2], y1[3]);
          *(u32x4*)(xb + ro + bj * HALF) = w;
          f32x4 r0 = {bflo(w[0]), bfhi(w[0]), bflo(w[1]), bfhi(w[1])}, r1 = {bflo(w[2]), bfhi(w[2]), bflo(w[3]), bfhi(w[3])};
          ss += r0[0]*r0[0] + r0[1]*r0[1] + r0[2]*r0[2] + r0[3]*r0[3] + r1[0]*r1[0] + r1[1]*r1[1] + r1[2]*r1[2] + r1[3]*r1[3];
        }
        ss += __shfl_xor(ss, 16); ss += __shfl_xor(ss, 32);
        if (fq == 0) rs[(u.pn * 4 + wc) * TH + row0 + ai * HALF + m * 16] = ss;
      }
      __builtin_amdgcn_sched_barrier(0);
    }
  }
};
struct EpiStore {
  u16* out; const float* rs; int ldc; int pad_;
  DI void operator()(const f32x4 (&acc)[2][2][4][2], const Unit& u, int wr, int wc, int fr, int fq, int tid) const {
    const int row0 = u.pm * 256 + wr * 64 + fr, col0 = u.pn * 256 + wc * 32 + 8 * fq;
#pragma unroll
    for (int ai = 0; ai < 2; ++ai)
#pragma unroll
      for (int m = 0; m < 4; ++m) {
        u16* rowp = out + (size_t)(row0 + ai * HALF + m * 16) * ldc + col0;
        const float rr = rtab_get(u.pm, wr * 64 + fr + ai * HALF + m * 16);
#pragma unroll
        for (int bj = 0; bj < 2; ++bj) {
          f32x4 v0 = acc[ai][bj][m][0] * rr, v1 = acc[ai][bj][m][1] * rr;
          u32x4 w; w[0] = pack2(v0[0], v0[1]); w[1] = pack2(v0[2], v0[3]); w[2] = pack2(v1[0], v1[1]); w[3] = pack2(v1[2], v1[3]);
          *(u32x4*)(rowp + bj * HALF) = w;
        }
      }
  }
};
struct EpiGate {
  const float* bias; unsigned* gs;
  DI void operator()(const f32x4 (&acc)[2][2][4][2], const Unit& u, int wr, int wc, int fr, int fq, int tid) const {
    const int col0 = u.pn * 256 + wc * 32 + 8 * fq;
    float rr[2][4];
#pragma unroll
    for (int ai = 0; ai < 2; ++ai)
#pragma unroll
      for (int m = 0; m < 4; ++m) rr[ai][m] = rtab_get(u.pm, wr * 64 + fr + ai * HALF + m * 16);
#pragma unroll
    for (int bj = 0; bj < 2; ++bj) {
      f32x4 b0 = *(const f32x4*)(bias + u.n * DM + col0 + bj * HALF), b1 = *(const f32x4*)(bias + u.n * DM + col0 + bj * HALF + 4);
#pragma unroll
      for (int ai = 0; ai < 2; ++ai)
#pragma unroll
        for (int m = 0; m < 4; ++m)
#pragma unroll
          for (int nn = 0; nn < 2; ++nn) {
            const int idx = ((ai * 2 + bj) * 4 + m) * 2 + nn;
            f32x4 v = acc[ai][bj][m][nn] * rr[ai][m] + (nn ? b1 : b0);
            unsigned qv[4];
#pragma unroll
            for (int j = 0; j < 4; ++j) { const float s = __builtin_amdgcn_rcpf(1.0f + __expf(-v[j])); unsigned qq = (unsigned)(s * 255.0f + 0.5f); qv[j] = qq < 1u ? 1u : qq; }
            gs[(u.n * 32 + idx) * NTHR + tid] = qv[0] | (qv[1] << 8) | (qv[2] << 16) | (qv[3] << 24);
          }
    }
  }
};
struct EpiBranchCarry {
  const unsigned* gs; u16* out;
  DI void operator()(f32x4 (&acc)[2][2][4][2], const Unit& u, int wr, int wc, int fr, int fq, int tid) const {
    const int row0 = u.pm * 256 + wr * 64 + fr, col0 = u.pn * 256 + wc * 32 + 8 * fq;
    const int n = u.n;
#pragma unroll
    for (int ai = 0; ai < 2; ++ai) {
      unsigned g0[16], g1[16];
#pragma unroll
      for (int k = 0; k < 16; ++k) {
        g0[k] = gs[(n * 32 + ai * 16 + k) * NTHR + tid];
        g1[k] = (n < 3) ? gs[((n + 1) * 32 + ai * 16 + k) * NTHR + tid] : 0xffffffffu;
      }
#pragma unroll
      for (int bj = 0; bj < 2; ++bj)
#pragma unroll
        for (int m = 0; m < 4; ++m) {
#pragma unroll
          for (int nn = 0; nn < 2; ++nn) {
            const int k = (bj * 4 + m) * 2 + nn;
            const unsigned a0 = g0[k], a1 = g1[k];
            f32x4 a = acc[ai][bj][m][nn];
            a[0] *= (float)(a0 & 255u) * __builtin_amdgcn_rcpf((float)(a1 & 255u)); a[1] *= (float)((a0 >> 8) & 255u) * __builtin_amdgcn_rcpf((float)((a1 >> 8) & 255u));
            a[2] *= (float)((a0 >> 16) & 255u) * __builtin_amdgcn_rcpf((float)((a1 >> 16) & 255u)); a[3] *= (float)(a0 >> 24) * __builtin_amdgcn_rcpf((float)(a1 >> 24));
            acc[ai][bj][m][nn] = a;
          }
          if (n == 3) {
            f32x4 r0 = acc[ai][bj][m][0], r1 = acc[ai][bj][m][1];
            u32x4 w; w[0] = pack2(r0[0], r0[1]); w[1] = pack2(r0[2], r0[3]); w[2] = pack2(r1[0], r1[1]); w[3] = pack2(r1[2], r1[3]);
            *(u32x4*)(out + (size_t)(row0 + ai * HALF + m * 16) * DM + col0 + bj * HALF) = w;
          }
        }
      __builtin_amdgcn_sched_barrier(0);
    }
  }
};

template <bool KEEP = false, class Epi, class Sched>
DI void gemm_phase(const Gemm g, const Sched S, const Epi E) {
  LAS unsigned char* lds = (LAS unsigned char*)smem;
  const int tid = tid_fresh(), wid = __builtin_amdgcn_readfirstlane(tid >> 6), lane = tid & 63, wr = wid >> 2, wc = wid & 3, fr = lane & 15, fq = lane >> 4;
  const int K = g.K, lda = g.lda, nt = K / BK;
  unsigned voffA[2], voffB[2];
#pragma unroll
  for (int i = 0; i < 2; ++i) { int R, C; stage_rc(tid * 16 + i * 8192, R, C); const int Rb = (R & ~31) + perm32(R & 31);
    voffA[i] = (unsigned)(R * lda + C) * 2u; voffB[i] = (unsigned)(Rb * K + C) * 2u; }
  const size_t kstep = (size_t)(BK * 2);
  const size_t hstepA = (size_t)HALF * lda * 2, hstepB = (size_t)HALF * K * 2;
  const size_t tstepA = 2 * hstepA, tstepB = 2 * hstepB;
  const unsigned ldsw = (unsigned)wid * 1024u;
  const int aoff = lds_byte(wr * 64 + fr, fq * 8), boff = lds_byte(wc * 32 + fr, fq * 8);
#define PG8_SA(b, h) (((b) * 2 + (h)) * HTB)
#define PG8_SB(b, h) ((4 + (b) * 2 + (h)) * HTB)
#define PG8_STAGE(bufoff, gbase, voff) do { _Pragma("unroll") for (int _i = 0; _i < 2; ++_i) \
    __builtin_amdgcn_global_load_lds((const unsigned*)((const char*)(gbase) + (voff)[_i]), (LAS unsigned*)(lds + (bufoff) + ldsw + _i * 8192), 16, 0, 0); } while (0)
#define PG8_LDA(dst, b, h) do { _Pragma("unroll") for (int m = 0; m < 4; ++m) _Pragma("unroll") for (int k = 0; k < 2; ++k) dst[m][k] = *(const LAS bf16x8*)(lds + PG8_SA(b, h) + aoff + m * 2048 + k * 1024); } while (0)
#define PG8_LDB(dst, b, h) do { _Pragma("unroll") for (int n = 0; n < 2; ++n) _Pragma("unroll") for (int k = 0; k < 2; ++k) dst[n][k] = *(const LAS bf16x8*)(lds + PG8_SB(b, h) + boff + n * 2048 + k * 1024); } while (0)
#define PG8_MMA(ai, bj, At, Bt) do { __builtin_amdgcn_s_setprio(1); _Pragma("unroll") for (int m = 0; m < 4; ++m) _Pragma("unroll") for (int n = 0; n < 2; ++n) _Pragma("unroll") for (int k = 0; k < 2; ++k) \
    acc[ai][bj][m][n] = __builtin_amdgcn_mfma_f32_16x16x32_bf16(Bt[n][k], At[m][k], acc[ai][bj][m][n], 0, 0, 0); __builtin_amdgcn_s_setprio(0); } while (0)
#define PG8_WAIT_V(n) asm volatile("s_waitcnt vmcnt(" #n ")" ::: "memory")
#define PG8_WAIT_L(n) asm volatile("s_waitcnt lgkmcnt(" #n ")" ::: "memory")
#define PG8_BAR __builtin_amdgcn_s_barrier()
#define PG8_SCHED __builtin_amdgcn_sched_barrier(0)
  Unit cur, nxt; int ui = 0;
  if (!S.next(0, cur)) return;
  f32x4 acc[2][2][4][2];
#pragma unroll
  for (int a = 0; a < 2; ++a)
#pragma unroll
    for (int b = 0; b < 2; ++b)
#pragma unroll
      for (int m = 0; m < 4; ++m)
#pragma unroll
        for (int n = 0; n < 2; ++n) acc[a][b][m][n] = (f32x4){0.f, 0.f, 0.f, 0.f};
  bf16x8 At[4][2], B0[2][2], B1[2][2];
  const char* cA = (const char*)g.A + cur.aoff * 2 + (size_t)cur.pm * tstepA; const char* cB = (const char*)g.Bt + cur.boff * 2 + (size_t)cur.pn * tstepB;
  PG8_STAGE(PG8_SB(0, 0), cB, voffB); PG8_STAGE(PG8_SA(0, 0), cA, voffA); PG8_STAGE(PG8_SB(0, 1), cB + hstepB, voffB); PG8_STAGE(PG8_SA(0, 1), cA + hstepA, voffA);
  if (wr == 1) PG8_BAR;
  PG8_WAIT_V(4); PG8_BAR;
  PG8_STAGE(PG8_SB(1, 0), cB + kstep, voffB); PG8_STAGE(PG8_SA(1, 0), cA + kstep, voffA); PG8_STAGE(PG8_SB(1, 1), cB + hstepB + kstep, voffB);
  PG8_WAIT_V(6); PG8_BAR;
  for (;;) {
    const bool has_next = S.next(ui + 1, nxt);
    const char* nA = has_next ? (const char*)g.A + nxt.aoff * 2 + (size_t)nxt.pm * tstepA : cA; const char* nB = has_next ? (const char*)g.Bt + nxt.boff * 2 + (size_t)nxt.pn * tstepB : cB;
    for (int t = 0; t < nt; t += 2) {
      const bool last = (t == nt - 2);
      const char* a1 = cA + (size_t)(t + 1) * kstep;
      const char* a2 = last ? nA : cA + (size_t)(t + 2) * kstep; const char* b2 = last ? nB : cB + (size_t)(t + 2) * kstep;
      const char* a3 = a2 + kstep; const char* b3 = b2 + kstep;
      PG8_LDB(B0, 0, 0); PG8_SCHED; PG8_LDA(At, 0, 0); PG8_STAGE(PG8_SA(1, 1), a1 + hstepA, voffA);
      PG8_WAIT_L(8); PG8_BAR; PG8_WAIT_L(0); PG8_MMA(0, 0, At, B0); PG8_BAR; PG8_SCHED;
      PG8_LDB(B1, 0, 1); PG8_STAGE(PG8_SB(0, 0), b2, voffB);
      PG8_BAR; PG8_WAIT_L(0); PG8_MMA(0, 1, At, B1); PG8_BAR;
      PG8_LDA(At, 0, 1); PG8_STAGE(PG8_SA(0, 0), a2, voffA);
      PG8_BAR; PG8_WAIT_L(0); PG8_MMA(1, 0, At, B0); PG8_BAR; PG8_SCHED;
      PG8_STAGE(PG8_SB(0, 1), b2 + hstepB, voffB);
      PG8_WAIT_V(6); PG8_BAR; PG8_MMA(1, 1, At, B1); PG8_BAR;
      PG8_LDB(B0, 1, 0); PG8_SCHED; PG8_LDA(At, 1, 0); PG8_STAGE(PG8_SA(0, 1), a2 + hstepA, voffA);
      PG8_WAIT_L(8); PG8_BAR; PG8_WAIT_L(0); PG8_MMA(0, 0, At, B0); PG8_BAR; PG8_SCHED;
      PG8_LDB(B1, 1, 1); PG8_STAGE(PG8_SB(1, 0), b3, voffB);
      PG8_BAR; PG8_WAIT_L(0); PG8_MMA(0, 1, At, B1); PG8_BAR;
      PG8_LDA(At, 1, 1); PG8_STAGE(PG8_SA(1, 0), a3, voffA);
      PG8_BAR; PG8_WAIT_L(0); PG8_MMA(1, 0, At, B0); PG8_BAR; PG8_SCHED;
      PG8_STAGE(PG8_SB(1, 1), b3 + hstepB, voffB);
      PG8_WAIT_V(6); PG8_BAR; PG8_MMA(1, 1, At, B1); PG8_BAR;
    }
    E(acc, cur, wr, wc, fr, fq, wid * 64 + lane);
    if (!has_next) break;
    if (!KEEP)
#pragma unroll
    for (int a = 0; a < 2; ++a)
#pragma unroll
      for (int b = 0; b < 2; ++b)
#pragma unroll
        for (int m = 0; m < 4; ++m)
#pragma unroll
          for (int n = 0; n < 2; ++n) acc[a][b][m][n] = (f32x4){0.f, 0.f, 0.f, 0.f};
    cur = nxt; cA = nA; cB = nB; ++ui;
  }
  PG8_WAIT_V(0);
  if (wr == 0) PG8_BAR;
  PG8_BAR;
#undef PG8_SA
#undef PG8_SB
#undef PG8_STAGE
#undef PG8_LDA
#undef PG8_LDB
#undef PG8_MMA
#undef PG8_WAIT_V
#undef PG8_WAIT_L
#undef PG8_BAR
#undef PG8_SCHED
}

DI Order make_order(int nN) { Order o; o.nN = nN; o.nwg = 128 * nN; o.G = gridDim.x; o.c = blockIdx.x; return o; }

DI void ld8(const u16* p, float (&o)[8]) {
  u32x4 w = *(const u32x4*)p;
#pragma unroll
  for (int i = 0; i < 4; ++i) { o[2*i] = bflo(w[i]); o[2*i+1] = bfhi(w[i]); }
}
DI void convpool_phase(const u16* __restrict__ z, u16* __restrict__ Y, const float* __restrict__ cw, int S) {
  const int total = (TH / 16) * 128;
  for (int it = blockIdx.x * NTHR + tid_fresh(); it < total; it += gridDim.x * NTHR) {
    const int c = it & 127, t0 = (it >> 7) * 16;
    const int s0 = t0 % S;
    const u16* zs = z + (long)(t0 - s0) * 2048;
    if (c < 64) {
      const int ch = c * 8;
      float w0[8], w1[8], w2[8];
#pragma unroll
      for (int i = 0; i < 8; ++i) { w0[i] = cw[ch + i]; w1[i] = cw[512 + ch + i]; w2[i] = cw[1024 + ch + i]; }
      float zc[18][8];
#pragma unroll
      for (int k = 0; k < 18; ++k) {
        const int s = s0 - 1 + k;
        const bool ok = (s >= 0) && (s < S);
        const int sc_ = ok ? s : s0;
        float a[8], b[8];
        ld8(zs + (long)sc_ * 2048 + ch, a); ld8(zs + (long)sc_ * 2048 + 1024 + ch, b);
#pragma unroll
        for (int i = 0; i < 8; ++i) zc[k][i] = ok ? a[i] * b[i] : 0.f;
      }
#pragma unroll
      for (int k = 0; k < 16; ++k) {
        float g[8];
        ld8(zs + (long)(s0 + k) * 2048 + 512 + ch, g);
        u32x4 o;
#pragma unroll
        for (int i = 0; i < 4; ++i) {
          float y0 = g[2*i] * (w0[2*i] * zc[k][2*i] + w1[2*i] * zc[k+1][2*i] + w2[2*i] * zc[k+2][2*i]);
          float y1 = g[2*i+1] * (w0[2*i+1] * zc[k][2*i+1] + w1[2*i+1] * zc[k+1][2*i+1] + w2[2*i+1] * zc[k+2][2*i+1]);
          o[i] = pack2(y0, y1);
        }
        *(u32x4*)(Y + (long)(t0 + k) * 2048 + ch) = o;
      }
    } else {
      const int ch = (c - 64) * 8;
      const int gi = ch >> 7, win = 2 << gi, hw = win >> 1;
      const u16* zb = zs + 1536 + ch;
      float sum[8];
#pragma unroll
      for (int i = 0; i < 8; ++i) sum[i] = 0.f;
#pragma unroll
      for (int k = 0; k < 16; ++k) {
        const int rr = s0 - hw + k;
        const bool ok = (k < win) && (rr >= 0) && (rr < S);
        float a[8]; ld8(zb + (long)(ok ? rr : s0) * 2048, a);
#pragma unroll
        for (int i = 0; i < 8; ++i) sum[i] += ok ? a[i] : 0.f;
      }
#pragma unroll
      for (int k = 0; k < 16; ++k) {
        const int s = s0 + k;
        int lo = s - hw, hi = lo + win; if (lo < 0) lo = 0; if (hi > S) hi = S;
        const float inv = __builtin_amdgcn_rcpf((float)(hi - lo));
        float pc[8]; ld8(zb + (long)s * 2048, pc);
        u32x4 o;
#pragma unroll
        for (int i = 0; i < 4; ++i) o[i] = pack2(sum[2*i] * inv - pc[2*i], sum[2*i+1] * inv - pc[2*i+1]);
        *(u32x4*)(Y + (long)(t0 + k) * 2048 + 512 + ch) = o;
        const int ra = s - hw + win, rr = s - hw;
        const bool oka = ra < S, okr = rr >= 0;
        float a[8], b[8];
        ld8(zb + (long)(oka ? ra : s) * 2048, a); ld8(zb + (long)(okr ? rr : s) * 2048, b);
#pragma unroll
        for (int i = 0; i < 8; ++i) sum[i] += (oka ? a[i] : 0.f) - (okr ? b[i] : 0.f);
      }
    }
  }
}

DI void qkprep_phase(u16* __restrict__ z, u16* __restrict__ VTg, u16* __restrict__ VTd, int S,
                     const float* __restrict__ gq, const float* __restrict__ gk,
                     const float* __restrict__ dgq, const float* __restrict__ dgk) {
  const int total = TH * 26;
  for (int it = blockIdx.x * NTHR + tid_fresh(); it < total; it += gridDim.x * NTHR) {
    const int t = it / 26, ci = it % 26;
    const int c = ci < 10 ? ci : ci + 2;
    u16* zp = z + (long)t * 2304 + c * 64;
    float v[64];
    float ss = 0.f;
#pragma unroll
    for (int i = 0; i < 8; ++i) {
      u32x4 w = *(const u32x4*)(zp + i * 8);
#pragma unroll
      for (int j = 0; j < 4; ++j) { v[i*8 + 2*j] = bflo(w[j]); v[i*8 + 2*j + 1] = bfhi(w[j]); }
    }
#pragma unroll
    for (int i = 0; i < 64; ++i) ss += v[i] * v[i];
    const float rs = rsqrtf(ss * (1.0f / 64.0f) + 1e-6f);
    const float* g = (c < 8) ? gq : (c < 10) ? gk : (c < 20) ? dgq : dgk;
    const bool isq = (c < 8) || (c >= 12 && c < 20);
    const float qs = isq ? 0.18033688011112042f : 1.0f;
#pragma unroll
    for (int i = 0; i < 64; ++i) v[i] = v[i] * rs * g[i];
    const int s = t % S;
    if (c < 10) {
      const float prow = (float)(s >> 6), pcol = (float)(s & 63);
#pragma unroll
      for (int part = 0; part < 2; ++part) {
        const float pos = part ? pcol : prow;
#pragma unroll
        for (int i = 0; i < 16; ++i) {
          const float fr = exp2f(-(float)i * (13.287712379549449f / 16.0f)) * 0.15915494309189535f;
          float rev = pos * fr; rev -= floorf(rev);
          float sn = __builtin_amdgcn_sinf(rev), cs = __builtin_amdgcn_cosf(rev);
          float x1 = v[part*32 + i], x2 = v[part*32 + 16 + i];
          v[part*32 + i] = x1 * cs - x2 * sn; v[part*32 + 16 + i] = x2 * cs + x1 * sn;
        }
      }
    } else {
      const float pos = (float)s;
#pragma unroll
      for (int i = 0; i < 8; ++i) {
        const float fr = exp2f(-(float)i * (18.931568569324174f / 8.0f)) * 0.15915494309189535f;
        float rev = pos * fr; rev -= floorf(rev);
        float sn = __builtin_amdgcn_sinf(rev), cs = __builtin_amdgcn_cosf(rev);
        float x1 = v[i], x2 = v[8 + i];
        v[i] = x1 * cs - x2 * sn; v[8 + i] = x2 * cs + x1 * sn;
      }
    }
#pragma unroll
    for (int i = 0; i < 8; ++i) {
      u32x4 w;
#pragma unroll
      for (int j = 0; j < 4; ++j) w[j] = pack2(v[i*8 + 2*j] * qs, v[i*8 + 2*j + 1] * qs);
      *(u32x4*)(zp + i * 8) = w;
    }
  }
  u16* tile = (u16*)smem;
  const int tid = tid_fresh();
  for (int tt = blockIdx.x; tt < TH / 64; tt += gridDim.x) {
    const int t0 = tt * 64, seq = t0 / S, s0 = t0 % S;
    {
      const int row = tid >> 3, ch = tid & 7;
#pragma unroll
      for (int cc = 0; cc < 10; ++cc) {
        const int col0 = (cc < 2) ? (640 + cc * 64) : (1792 + (cc - 2) * 64);
        *(u32x4*)(tile + cc * 4608 + row * 72 + ch * 8) = *(const u32x4*)(z + (long)(t0 + row) * 2304 + col0 + ch * 8);
      }
    }
    __syncthreads();
    {
      const int col = tid >> 3, tch = tid & 7;
#pragma unroll
      for (int cc = 0; cc < 10; ++cc) {
        u16* dst;
        if (cc < 2) dst = VTg + ((long)(seq * 2 + cc) * 64) * S + s0;
        else { int j = cc - 2; dst = VTd + ((long)(seq * 4 + (j >> 1)) * 128 + (j & 1) * 64) * S + s0; }
        u32x4 w;
#pragma unroll
        for (int j = 0; j < 4; ++j) w[j] = (unsigned)tile[cc * 4608 + (tch * 8 + 2*j) * 72 + col] | ((unsigned)tile[cc * 4608 + (tch * 8 + 2*j + 1) * 72 + col] << 16);
        *(u32x4*)(dst + (long)col * S + tch * 8) = w;
      }
    }
    __syncthreads();
  }
}

#define MFMA32(a, b, c) __builtin_amdgcn_mfma_f32_32x32x16_bf16((a), (b), (c), 0, 0, 0)

template <int DIFF>
DI void attn_item(const u16* __restrict__ zq, const u16* __restrict__ VT, u16* __restrict__ Y, const int S,
                  const int tok0, const int vtrow0, const int qcol0, const int qcol1, const int kcol0, const int kcol1,
                  const int ycol, const int qb, const float nshift, const float lam,
                  const float* __restrict__ onorm, const float oscale) {
  constexpr int NK = DIFF ? 2 : 1, NQ = DIFF ? 1 : 2, NDV = DIFF ? 4 : 2, DV = NDV * 32, KSTR = 72;
  constexpr int KT = DIFF ? 128 : 64;
  constexpr int VSTR = KT + 8;
  constexpr int KI = KT / 64;
  constexpr int VI = DV * (KT / 8) / NTHR;
  u16* Ks = (u16*)smem;
  u16* Vs = Ks + 2 * NK * KT * KSTR;
  const int tid = tid_fresh(), wid = tid >> 6, lane = tid & 63, r = lane & 31, h = lane >> 5;
  const int rs = (r & 0x13) | ((r & 4) << 1) | ((r & 8) >> 1);
  const int csub = DIFF ? (wid >> 2) : 0;
  const int q = DIFF ? (tok0 + qb * 128 + (wid & 3) * 32 + r) : (tok0 + qb * 256 + wid * 32 + r);
  bf16x8 qf[NQ][4];
#pragma unroll
  for (int t = 0; t < 4; ++t) {
    qf[0][t] = *(const bf16x8*)(zq + (long)q * 2304 + (DIFF ? (csub ? qcol1 : qcol0) : qcol0) + t * 16 + h * 8);
    if (NQ == 2) qf[NQ - 1][t] = *(const bf16x8*)(zq + (long)q * 2304 + qcol1 + t * 16 + h * 8);
  }
  f32x16 o[NQ][NDV];
#pragma unroll
  for (int a = 0; a < NQ; ++a)
#pragma unroll
    for (int d = 0; d < NDV; ++d)
#pragma unroll
      for (int i = 0; i < 16; ++i) o[a][d][i] = 0.f;
  float ls0 = 0.f, ls1 = 0.f;
  f32x16 nsv;
#pragma unroll
  for (int i = 0; i < 16; ++i) nsv[i] = nshift;
  const int lrow = tid >> 3, lch = tid & 7;
  constexpr int VCH = KT / 8;
  const int vrow = tid / VCH, vch = tid % VCH;
  constexpr int VRS = NTHR / VCH;
  u32x4 kreg[NK][KI], vreg[VI];
  const u16* kbase = zq + (long)(tok0 + lrow) * 2304 + lch * 8;
  const u16* vbase = VT + (long)(vtrow0 + vrow) * S + vch * 8;
  const int nkt = S / KT;
#define GLOAD(kt) do { \
    for (int _i = 0; _i < KI; ++_i) { kreg[0][_i] = *(const u32x4*)(kbase + (long)((kt) * KT + 64 * _i) * 2304 + kcol0); \
      if (NK == 2) kreg[NK - 1][_i] = *(const u32x4*)(kbase + (long)((kt) * KT + 64 * _i) * 2304 + kcol1); } \
    for (int _i = 0; _i < VI; ++_i) vreg[_i] = *(const u32x4*)(vbase + (long)(VRS * _i) * S + (kt) * KT); } while (0)
#define LSTORE(st) do { for (int _k = 0; _k < NK; ++_k) for (int _i = 0; _i < KI; ++_i) *(u32x4*)(Ks + (((st) * NK + _k) * KT + lrow + 64 * _i) * KSTR + lch * 8) = kreg[_k][_i]; \
    for (int _i = 0; _i < VI; ++_i) *(u32x4*)(Vs + ((st) * DV + vrow + VRS * _i) * VSTR + vch * 8) = vreg[_i]; } while (0)
  GLOAD(0); LSTORE(0);
#pragma unroll
  for (int a = 0; a < NQ; ++a)
#pragma unroll
    for (int t = 0; t < 4; ++t) asm volatile("" :: "v"(qf[a][t]));
  __syncthreads();
  for (int kt = 0; kt < nkt; ++kt) {
    const int st = kt & 1;
    if (kt + 1 < nkt) GLOAD(kt + 1);
    const u16* Kb = Ks + (st * NK + csub) * KT * KSTR;
    const u16* Vb = Vs + st * DV * VSTR;
#define SB_ __builtin_amdgcn_sched_barrier(0)
#define SOFTMAX_PACK(SC, LS, PF) do { \
      _Pragma("unroll") for (int i = 0; i < 16; ++i) SC[i] = __builtin_amdgcn_exp2f(SC[i]); \
      f32x2_t ps2_ = {SC[0], SC[1]}; \
      _Pragma("unroll") for (int i = 1; i < 8; ++i) { f32x2_t t2_ = {SC[2 * i], SC[2 * i + 1]}; ps2_ += t2_; } \
      LS += ps2_[0] + ps2_[1]; \
      _Pragma("unroll") for (int k2 = 0; k2 < 2; ++k2) { u32x4 pk_; \
        _Pragma("unroll") for (int j = 0; j < 4; ++j) pk_[j] = pack2(SC[8 * k2 + 2 * j], SC[8 * k2 + 2 * j + 1]); \
        PF[k2] = __builtin_bit_cast(bf16x8, pk_); } } while (0)
    if (DIFF) {
#pragma unroll
     for (int kp = 0; kp < KT / 64; ++kp) {
      const int k0 = kp * 64;
      bf16x8 kfA[4], kfB[4];
#pragma unroll
      for (int t = 0; t < 4; ++t) { kfA[t] = *(const bf16x8*)(Kb + (k0 + rs) * KSTR + t * 16 + h * 8); kfB[t] = *(const bf16x8*)(Kb + (k0 + 32 + rs) * KSTR + t * 16 + h * 8); }
      SB_;
      __builtin_amdgcn_s_setprio(1);
      f32x16 scA = MFMA32(kfA[0], qf[0][0], nsv);
#pragma unroll
      for (int t = 1; t < 4; ++t) scA = MFMA32(kfA[t], qf[0][t], scA);
      f32x16 scB = MFMA32(kfB[0], qf[0][0], nsv);
#pragma unroll
      for (int t = 1; t < 4; ++t) scB = MFMA32(kfB[t], qf[0][t], scB);
      __builtin_amdgcn_s_setprio(0);
      SB_;
      bf16x8 vf[2][NDV];
#pragma unroll
      for (int k2 = 0; k2 < 2; ++k2)
#pragma unroll
        for (int d = 0; d < NDV; ++d) vf[k2][d] = *(const bf16x8*)(Vb + (d * 32 + r) * VSTR + k0 + k2 * 16 + h * 8);
      bf16x8 pfA[2], pfB[2];
      SOFTMAX_PACK(scA, ls0, pfA);
      SB_;
      __builtin_amdgcn_s_setprio(1);
#pragma unroll
      for (int k2 = 0; k2 < 2; ++k2)
#pragma unroll
        for (int d = 0; d < NDV; ++d) o[0][d] = MFMA32(vf[k2][d], pfA[k2], o[0][d]);
      __builtin_amdgcn_s_setprio(0);
      SB_;
#pragma unroll
      for (int k2 = 0; k2 < 2; ++k2)
#pragma unroll
        for (int d = 0; d < NDV; ++d) vf[k2][d] = *(const bf16x8*)(Vb + (d * 32 + r) * VSTR + k0 + 32 + k2 * 16 + h * 8);
      SOFTMAX_PACK(scB, ls0, pfB);
      SB_;
      __builtin_amdgcn_s_setprio(1);
#pragma unroll
      for (int k2 = 0; k2 < 2; ++k2)
#pragma unroll
        for (int d = 0; d < NDV; ++d) o[0][d] = MFMA32(vf[k2][d], pfB[k2], o[0][d]);
      __builtin_amdgcn_s_setprio(0);
      SB_;
     }
    } else {
#pragma unroll
      for (int sub = 0; sub < 2; ++sub) {
        bf16x8 kf[4];
        bf16x8 vf[2][NDV];
#pragma unroll
        for (int t = 0; t < 4; ++t) kf[t] = *(const bf16x8*)(Kb + (sub * 32 + rs) * KSTR + t * 16 + h * 8);
#pragma unroll
        for (int k2 = 0; k2 < 2; ++k2)
#pragma unroll
          for (int d = 0; d < NDV; ++d) vf[k2][d] = *(const bf16x8*)(Vb + (d * 32 + r) * VSTR + sub * 32 + k2 * 16 + h * 8);
        SB_;
        __builtin_amdgcn_s_setprio(1);
        f32x16 sc0 = MFMA32(kf[0], qf[0][0], nsv);
#pragma unroll
        for (int t = 1; t < 4; ++t) sc0 = MFMA32(kf[t], qf[0][t], sc0);
        f32x16 sc1 = MFMA32(kf[0], qf[NQ - 1][0], nsv);
#pragma unroll
        for (int t = 1; t < 4; ++t) sc1 = MFMA32(kf[t], qf[NQ - 1][t], sc1);
        __builtin_amdgcn_s_setprio(0);
        SB_;
        bf16x8 pf0[2], pf1[2];
        SOFTMAX_PACK(sc0, ls0, pf0);
        SB_;
        __builtin_amdgcn_s_setprio(1);
#pragma unroll
        for (int k2 = 0; k2 < 2; ++k2)
#pragma unroll
          for (int d = 0; d < NDV; ++d) o[0][d] = MFMA32(vf[k2][d], pf0[k2], o[0][d]);
        __builtin_amdgcn_s_setprio(0);
        SB_;
        SOFTMAX_PACK(sc1, ls1, pf1);
        SB_;
        __builtin_amdgcn_s_setprio(1);
#pragma unroll
        for (int k2 = 0; k2 < 2; ++k2)
#pragma unroll
          for (int d = 0; d < NDV; ++d) o[NQ - 1][d] = MFMA32(vf[k2][d], pf1[k2], o[NQ - 1][d]);
        __builtin_amdgcn_s_setprio(0);
        SB_;
      }
    }
#undef SB_
#undef SOFTMAX_PACK
    if (kt + 1 < nkt) LSTORE(st ^ 1);
    __syncthreads();
  }
#undef GLOAD
#undef LSTORE
  const float l0 = ls0 + __shfl_xor(ls0, 32);
  const float i0 = 1.0f / l0;
  if (!DIFF) {
    const float l1 = ls1 + __shfl_xor(ls1, 32);
    const float i1 = 1.0f / l1;
#pragma unroll
    for (int hh = 0; hh < NQ; ++hh)
#pragma unroll
      for (int d = 0; d < NDV; ++d)
#pragma unroll
        for (int g = 0; g < 4; ++g) {
          const float iv = hh ? i1 : i0;
          u32x2 w;
          w[0] = pack2(o[hh][d][4*g] * iv, o[hh][d][4*g+1] * iv);
          w[1] = pack2(o[hh][d][4*g+2] * iv, o[hh][d][4*g+3] * iv);
          *(u32x2*)(Y + (long)q * 2048 + ycol + hh * 64 + d * 32 + 8 * g + 4 * h) = w;
        }
  } else {
    float* exch = (float*)smem + (wid & 3) * 4096 + lane;
    if (csub == 1) {
#pragma unroll
      for (int d = 0; d < NDV; ++d)
#pragma unroll
        for (int i = 0; i < 16; ++i) exch[(d * 16 + i) * 64] = o[0][d][i] * i0;
    }
    __syncthreads();
    if (csub == 0) {
      float ss = 0.f;
#pragma unroll
      for (int d = 0; d < NDV; ++d)
#pragma unroll
        for (int i = 0; i < 16; ++i) { float v = o[0][d][i] * i0 - lam * exch[(d * 16 + i) * 64]; o[0][d][i] = v; ss += v * v; }
      ss += __shfl_xor(ss, 32);
      const float rn = rsqrtf(ss * (1.0f / 128.0f) + 1e-6f) * oscale;
#pragma unroll
      for (int d = 0; d < NDV; ++d)
#pragma unroll
        for (int g = 0; g < 4; ++g) {
          const int dv = d * 32 + 8 * g + 4 * h;
          f32x4 gn = *(const f32x4*)(onorm + dv);
          u32x2 w;
          w[0] = pack2(o[0][d][4*g] * rn * gn[0], o[0][d][4*g+1] * rn * gn[1]);
          w[1] = pack2(o[0][d][4*g+2] * rn * gn[2], o[0][d][4*g+3] * rn * gn[3]);
          *(u32x2*)(Y + (long)q * 2048 + ycol + dv) = w;
        }
    }
    __syncthreads();
  }
}

DI float wave_max_abs64(const float* g) {
  float v = fabsf(g[tid_fresh() & 63]);
#pragma unroll
  for (int o = 32; o > 0; o >>= 1) v = fmaxf(v, __shfl_xor(v, o));
  return v;
}

DI void attn_phase(const Params& p, int l, int S, const u16* zq, const u16* VTg, const u16* VTd, u16* Y) {
  const float L2E = 1.4426950408889634f;
  const float* gq = p.in[11] + l * 64; const float* gk = p.in[12] + l * 64;
  const float* dgq = p.in[13] + l * 64; const float* dgk = p.in[14] + l * 64;
  const float shift_g = -8.0f * 1.02f * wave_max_abs64(gq) * wave_max_abs64(gk) * L2E;
  const float shift_d = -8.0f * 1.02f * wave_max_abs64(dgq) * wave_max_abs64(dgk) * L2E;
  const float* lv = p.in[15] + l * 256;
  const int ln_ = tid_fresh() & 63;
  float a = lv[ln_] * lv[64 + ln_], b = lv[128 + ln_] * lv[192 + ln_];
#pragma unroll
  for (int o = 32; o > 0; o >>= 1) { a += __shfl_xor(a, o); b += __shfl_xor(b, o); }
  const float lam_init = (l == 0) ? 0.2f : 0.3555090675909693f;
  const float lam = expf(a) - expf(b) + lam_init;
  const float* onorm = p.in[16] + l * 128;
  const int b_ = blockIdx.x, x = b_ & 7, bi = b_ >> 3;
  {
    const int nqb = S / 128;
    for (int rr = 0; rr < 4; ++rr) {
      const int lin = rr * 256 + x * 32 + bi;
      const int combo = lin / nqb, qb = lin % nqb, seq = combo >> 2, hd = combo & 3;
      attn_item<1>(zq, VTd, Y, S, seq * S, (seq * 4 + hd) * 128, 768 + hd * 128, 768 + hd * 128 + 64,
                   1280 + hd * 128, 1280 + hd * 128 + 64, 1536 + hd * 128, qb, shift_d, lam, onorm, 1.0f - lam_init);
    }
  }
  {
    const int nqb = S / 256;
    for (int rr = 0; rr < 2; ++rr) {
      const int lin = rr * 256 + x * 32 + bi;
      const int combo = lin / nqb, qb = lin % nqb, seq = combo >> 2, hd = combo & 3;
      const int kvh = hd >> 1;
      attn_item<0>(zq, VTg, Y, S, seq * S, (seq * 2 + kvh) * 64, hd * 128, hd * 128 + 64,
                   512 + kvh * 64, 512 + kvh * 64, 1024 + hd * 128, qb, shift_g, 0.f, onorm, 1.0f);
    }
  }
}

DI void branch_phase(const u16* XN, const u16* Y, const u16* WG, const u16* WB, const float* bgate,
                     u16* merged, u16* gs_all, float* ms_all, const float* rs) {
  unsigned* gs = (unsigned*)(ms_all + (long)blockIdx.x * 65536);
  Order o = make_order(4);
  for (int i = 0;; ++i) {
    Unit u; if (!o.next(i, u)) break;
    {
      Gemm g1; g1.A = XN; g1.lda = DM; g1.Bt = WG; g1.K = DM;
      GateSteps gsch; gsch.pm = u.pm; gsch.pn = u.pn;
      EpiGate e1; e1.bias = bgate; e1.gs = gs;
      gemm_phase(g1, gsch, e1);
    }
    Gemm g2; g2.A = Y; g2.lda = 2048; g2.Bt = WB; g2.K = 512;
    BranchSteps bs; bs.pm = u.pm; bs.pn = u.pn;
    EpiBranchCarry e2; e2.gs = gs; e2.out = merged;
    gemm_phase<true>(g2, bs, e2);
  }
}

__global__ void __launch_bounds__(NTHR) mega(Params p) {
  cg::grid_group grid = cg::this_grid();
  volatile XLAS unsigned* xst = (volatile XLAS unsigned*)(smem + 147456);
  if (threadIdx.x == 0) { xst[0] = 0u; xst[1] = 0u; xst[2] = 0u; xst[3] = 0u; }
  __syncthreads();
  if (blockIdx.x == 0) { unsigned* bw = (unsigned*)(p.ws + WS_BAR); for (int i = threadIdx.x; i < XCD_BAR_WORDS; i += NTHR) bw[i] = 0u; }
  prep_weights(p);
  xb_phase(p.in[0], (u16*)(p.ws + WS_XN), (float*)(p.ws + WS_RS) + 32 * TH);
  grid.sync();
  XcdBarrier xbar = xcd_barrier_post((unsigned*)(p.ws + WS_BAR), xst);

  u16* W = (u16*)(p.ws + WS_W);
  u16* XN = (u16*)(p.ws + WS_XN);
  u16* Y = (u16*)(p.ws + WS_Y);
  char* BIG = p.ws + WS_BIG;
  float* RSa = (float*)(p.ws + WS_RS);
  float* RSb = RSa + 16 * TH;
  float* RSc = RSb + 16 * TH;
  for (int hf = 0; hf < 2; ++hf) {
    const int S = hf == 0 ? 8192 : 2048;
    const float* xin = p.in[hf];
    float* xo = p.out + (long)hf * TH * DM;
    if (hf == 1) {
      xb_phase(xin, XN, RSc);
      xcd_barrier(xbar);
    }
    for (int l = 0; l < 2; ++l) {
      const u16* Wl = W + (long)l * WLAYER;
      rs_prologue(RSc);
      { Gemm g; g.A = XN; g.lda = DM; g.Bt = Wl + oF1U; g.K = DM; EpiSwiglu e; e.out = (u16*)BIG; e.rs = RSc; gemm_phase(g, make_order(22), e); }
      xcd_barrier(xbar);
      { Gemm g; g.A = (u16*)BIG; g.lda = FF; g.Bt = Wl + oF1D; g.K = FF; EpiResid e; e.xd = nullptr; e.al = 0.5f; e.xb = XN; e.rs = RSa; e.pad_ = 0; gemm_phase(g, make_order(4), e); }
      xcd_barrier(xbar);
      rs_prologue(RSa);
      { Gemm g; g.A = XN; g.lda = DM; g.Bt = Wl + oWCP; g.K = DM; EpiStore e; e.out = (u16*)BIG; e.ldc = 2048; e.rs = RSa; gemm_phase(g, make_order(8), e); }
      xcd_barrier(xbar);
      convpool_phase((const u16*)BIG, Y, p.in[8] + l * 1536, S);
      xcd_barrier(xbar);
      rs_prologue(RSa);
      { Gemm g; g.A = XN; g.lda = DM; g.Bt = Wl + oWQKV; g.K = DM; EpiStore e; e.out = (u16*)BIG; e.ldc = 2304; e.rs = RSa; gemm_phase(g, make_order(9), e); }
      xcd_barrier(xbar);
      qkprep_phase((u16*)BIG, (u16*)(BIG + BIG_VTG), (u16*)(BIG + BIG_VTD), S,
                   p.in[11] + l * 64, p.in[12] + l * 64, p.in[13] + l * 64, p.in[14] + l * 64);
      xcd_barrier(xbar);
      attn_phase(p, l, S, (const u16*)BIG, (const u16*)(BIG + BIG_VTG), (const u16*)(BIG + BIG_VTD), Y);
      xcd_barrier(xbar);
      rs_prologue(RSa);
      branch_phase(XN, Y, Wl + oWG, Wl + oWB, p.in[7] + l * 4096, (u16*)BIG, (u16*)(BIG + BIG_GS), (float*)(BIG + BIG_MS), RSa);
      xcd_barrier(xbar);
      { Gemm g; g.A = (u16*)BIG; g.lda = DM; g.Bt = Wl + oWO; g.K = DM; EpiResid e; e.xd = nullptr; e.al = 1.0f; e.xb = XN; e.rs = RSb; e.pad_ = 0; gemm_phase(g, make_order(4), e); }
      xcd_barrier(xbar);
      rs_prologue(RSb);
      { Gemm g; g.A = XN; g.lda = DM; g.Bt = Wl + oF2U; g.K = DM; EpiSwiglu e; e.out = (u16*)BIG; e.rs = RSb; gemm_phase(g, make_order(22), e); }
      xcd_barrier(xbar);
      { Gemm g; g.A = (u16*)BIG; g.lda = FF; g.Bt = Wl + oF2D; g.K = FF; EpiResid e; e.xd = (l == 1) ? xo : nullptr; e.al = 0.5f; e.xb = XN; e.rs = RSc; e.pad_ = 0; gemm_phase(g, make_order(4), e); }
      xcd_barrier(xbar);
    }
  }
}

extern "C" void kernel_launch(void* const* d_in, const int* in_sizes, int n_in, void* d_out, int out_size,
                              void* d_ws, size_t ws_size, hipStream_t stream) {
  constexpr size_t kLds = 147456 + 16;
  static int inited = 0;
  if (!inited) {
    (void)hipFuncSetAttribute((const void*)mega, hipFuncAttributeMaxDynamicSharedMemorySize, (int)kLds);
    inited = 1;
  }
  Params p{};
  for (int i = 0; i < 22; ++i) p.in[i] = (const float*)d_in[i];
  p.out = (float*)d_out; p.ws = (char*)d_ws;
  void* args[] = {&p};
  hipError_t e = hipLaunchCooperativeKernel((void*)mega, dim3(NBLK), dim3(NTHR), args, kLds, stream);
  if (e != hipSuccess) fprintf(stderr, "cooperative launch failed: %s\n", hipGetErrorString(e));
}
```
